# Optimizing an MI355X kernel written in HIP

```python
import jax
import jax.numpy as jnp
from jax import lax
import numpy as np

D_MODEL = 1024
BATCH = 4
SEQ = 4096
DEPTH = 2
DEC_BATCH = 128
DEC_SEQ = 1
PAST_LEN = 2048
PAGE_SIZE = 128

EPS = 1e-6
D_CONV = D_MODEL // 2
CONV_W = 3
D_CHUNK = D_MODEL // 2
N_CHUNK_HEADS = 4
CHUNK_HD = D_CHUNK // N_CHUNK_HEADS
CHUNK = 128
HEAD_DIM = 64
N_HEADS = D_MODEL // HEAD_DIM
N_KV = 4
HPG = N_HEADS // N_KV
CMP_BLOCK = 32
CMP_STRIDE = 16
SEL_BLOCK = 64
TOP_N = 16
WINDOW = 512
QBLOCK = 128
ROPE_THETA = 10000.0
SCALE = HEAD_DIM ** -0.5
NEG_INF = -1e30
FORCE_BONUS = 1e4
D_FF = ((8 * D_MODEL + 2) // 3 + 255) // 256 * 256

kernel_name = "hybrid_conv_chunkmlp_nsa_decoder_step"


def rmsnorm(x, g):
    xf = x.astype(jnp.float32)
    y = xf * lax.rsqrt(jnp.mean(xf * xf, axis=-1, keepdims=True) + EPS)
    return (y * g.astype(jnp.float32)).astype(x.dtype)


def rope(x, pos):
    half = HEAD_DIM // 2
    inv = ROPE_THETA ** (-jnp.arange(half, dtype=jnp.float32) * 2.0 / HEAD_DIM)
    ang = pos.astype(jnp.float32)[:, None] * inv[None, :]
    shape = (pos.shape[0],) + (1,) * (x.ndim - 3) + (HEAD_DIM,)
    cos = jnp.concatenate([jnp.cos(ang), jnp.cos(ang)], -1).reshape(shape)
    sin = jnp.concatenate([jnp.sin(ang), jnp.sin(ang)], -1).reshape(shape)
    xf = x.astype(jnp.float32)
    rot = jnp.concatenate([-xf[..., half:], xf[..., :half]], -1)
    return (xf * cos + rot * sin).astype(x.dtype)


def swiglu(x, w_in, w_out):
    a, b = jnp.split(x @ w_in, 2, axis=-1)
    return (jax.nn.silu(a) * b) @ w_out


def chunk_mix(v, w_spatial, b_spatial):
    n, t, _ = v.shape
    nch = -(-t // CHUNK)
    tp = nch * CHUNK
    vp = jnp.pad(v, ((0, 0), (0, tp - t), (0, 0))).reshape(n, nch, CHUNK, N_CHUNK_HEADS, CHUNK_HD)
    causal = jnp.tril(jnp.ones((CHUNK, CHUNK), dtype=bool))
    w = jnp.where(causal[None], w_spatial, 0)
    mixed = jnp.einsum('hts,ncshd->ncthd', w, vp) + b_spatial.T[:, :, None]
    return mixed.reshape(n, tp, D_CHUNK)[:, :t]


def conv_chunk_mixer(x, conv_hist, w_in0, conv_w, norm_v, w_spatial, b_spatial, w_out0):
    t = x.shape[1]
    h = x @ w_in0
    b_gate, c_gate, h_conv, u, v = jnp.split(
        h, [D_CONV, 2 * D_CONV, 3 * D_CONV, 3 * D_CONV + D_CHUNK], axis=-1)
    z = c_gate * h_conv
    zh = jnp.concatenate([conv_hist.astype(z.dtype), z], axis=1)
    conv = conv_w[0] * zh[:, 0:t]
    for j in range(1, CONV_W):
        conv = conv + conv_w[j] * zh[:, j:j + t]
    y_conv = b_gate * conv
    vn = rmsnorm(jax.nn.gelu(v), norm_v)
    y_chunk = jax.nn.gelu(u) * chunk_mix(vn, w_spatial, b_spatial)
    y = jnp.concatenate([y_conv, y_chunk], axis=-1) @ w_out0
    return y, zh[:, -(CONV_W - 1):], vn


def nsa_project(x, w_in1):
    n, t, _ = x.shape
    h = x @ w_in1
    q_dim = N_HEADS * HEAD_DIM
    kv_dim = 6 * N_KV * HEAD_DIM
    q = h[..., :q_dim].reshape(n, t, N_KV, HPG, HEAD_DIM)
    kv = h[..., q_dim:q_dim + kv_dim].reshape(n, t, 6, N_KV, HEAD_DIM)
    gates = jax.nn.sigmoid(h[..., q_dim + kv_dim:].astype(jnp.float32)).astype(x.dtype)
    return q, kv, gates.reshape(n, t, N_KV, HPG, 3)


def compress(k, pe, w):
    n, l, g, d = k.shape
    nseg = -(-l // CMP_STRIDE)
    kp = jnp.pad(k, ((0, 0), (0, nseg * CMP_STRIDE - l), (0, 0), (0, 0)))
    seg = kp.reshape(n, nseg, CMP_STRIDE, g, d)
    r = CMP_BLOCK // CMP_STRIDE
    nc = nseg - r + 1
    blocks = jnp.concatenate([seg[:, i:i + nc] for i in range(r)], axis=2)
    return jnp.einsum('nclgd,lde->ncge', blocks + pe[:, None, :], w)


def nsa_core(q, q_rot, qpos, ck, cv, fetch, wk, wv, wpos, gates, key_len):
    b, nq = q.shape[0], q.shape[1]
    nc = ck.shape[1]
    t = qpos[:, None]
    s = jnp.einsum('bqghd,bngd->bghqn', q, ck).astype(jnp.float32) * SCALE
    cvalid = (jnp.arange(nc) * CMP_STRIDE + CMP_BLOCK - 1)[None, :] <= t
    p_cmp = jnp.where(cvalid, jax.nn.softmax(jnp.where(cvalid, s, NEG_INF), axis=-1), 0.0)
    o_cmp = jnp.einsum('bghqn,bngd->bqghd', p_cmp.astype(cv.dtype), cv)
    ns = -(-key_len // SEL_BLOCK)
    cstart = jnp.arange(nc) * CMP_STRIDE
    sstart = jnp.arange(ns) * SEL_BLOCK
    overlap = ((cstart[:, None] < sstart[None, :] + SEL_BLOCK)
               & (cstart[:, None] + CMP_BLOCK > sstart[None, :])).astype(jnp.float32)
    imp = jnp.einsum('bghqn,nj->bgqj', p_cmp, overlap)
    cur = (qpos // SEL_BLOCK)[:, None]
    jj = jnp.arange(ns)[None, :]
    forced = (jj == 0) | (jj == cur) | (jj == cur - 1)
    svalid = sstart[None, :] <= t
    score = jnp.where(svalid, imp + jnp.where(forced, FORCE_BONUS, 0.0), NEG_INF)
    _, idx = lax.top_k(score, min(TOP_N, ns))
    kpos = (idx[..., None] * SEL_BLOCK + jnp.arange(SEL_BLOCK)).reshape(b, N_KV, nq, -1)
    k_sel, v_sel = fetch(kpos)
    s = jnp.einsum('bqghd,bgqkd->bghqk', q_rot, k_sel).astype(jnp.float32) * SCALE
    smask = (kpos <= qpos[None, None, :, None])[:, :, None]
    p_slc = jax.nn.softmax(jnp.where(smask, s, NEG_INF), axis=-1)
    o_slc = jnp.einsum('bghqk,bgqkd->bqghd', p_slc.astype(v_sel.dtype), v_sel)
    s = jnp.einsum('bqghd,bwgd->bghqw', q_rot, wk).astype(jnp.float32) * SCALE
    dist = t - wpos[None, :]
    wmask = (wpos[None, :] >= 0) & (dist >= 0) & (dist < WINDOW)
    p_win = jax.nn.softmax(jnp.where(wmask, s, NEG_INF), axis=-1)
    o_win = jnp.einsum('bghqw,bwgd->bqghd', p_win.astype(wv.dtype), wv)
    o = gates[..., 0:1] * o_cmp + gates[..., 1:2] * o_slc + gates[..., 2:3] * o_win
    return o.reshape(b, nq, N_HEADS * HEAD_DIM)


def nsa_prompt(x, w_in1, pe_cmp, w_cmp, w_out1):
    n, t, _ = x.shape
    pos = jnp.arange(t)
    q, kv, gates = nsa_project(x, w_in1)
    q_rot = rope(q, pos)
    k_cmp, v_cmp = kv[:, :, 0], kv[:, :, 1]
    k_slc, v_slc = rope(kv[:, :, 2], pos), kv[:, :, 3]
    k_win, v_win = rope(kv[:, :, 4], pos), kv[:, :, 5]
    ck = compress(k_cmp, pe_cmp[0], w_cmp[0])
    cv = compress(v_cmp, pe_cmp[1], w_cmp[1])
    pad = ((0, 0), (WINDOW, 0), (0, 0), (0, 0))
    kw_pad = jnp.pad(k_win, pad)
    vw_pad = jnp.pad(v_win, pad)
    bi = jnp.arange(n)[:, None, None, None]
    gi = jnp.arange(N_KV)[None, :, None, None]

    def fetch(kpos):
        p = jnp.clip(kpos, 0, t - 1)
        return k_slc[bi, p, gi], v_slc[bi, p, gi]

    def block(i):
        qs = i * QBLOCK
        qpos = qs + jnp.arange(QBLOCK)
        wpos = qs - WINDOW + jnp.arange(WINDOW + QBLOCK)
        qb = lax.dynamic_slice_in_dim(q, qs, QBLOCK, axis=1)
        qrb = lax.dynamic_slice_in_dim(q_rot, qs, QBLOCK, axis=1)
        gb = lax.dynamic_slice_in_dim(gates, qs, QBLOCK, axis=1)
        wk = lax.dynamic_slice_in_dim(kw_pad, qs, WINDOW + QBLOCK, axis=1)
        wv = lax.dynamic_slice_in_dim(vw_pad, qs, WINDOW + QBLOCK, axis=1)
        return nsa_core(qb, qrb, qpos, ck, cv, fetch, wk, wv, wpos, gb, t)

    o = lax.map(block, jnp.arange(t // QBLOCK))
    o = jnp.moveaxis(o, 0, 1).reshape(n, t, N_HEADS * HEAD_DIM)
    y = o @ w_out1
    kv_rows = jnp.stack([k_cmp, v_cmp, k_slc, v_slc], axis=2)
    win_rows = jnp.stack([k_win, v_win], axis=2)[:, t - min(WINDOW, t):]
    return y, kv_rows, win_rows


def nsa_sample(x, cache_kv, cache_win, page_table, w_in1, pe_cmp, w_cmp, w_out1):
    n, s_len, _ = x.shape
    past_len = page_table.shape[1] * PAGE_SIZE
    wb = cache_win.shape[1]
    qpos = past_len + jnp.arange(s_len)
    q, kv, gates = nsa_project(x, w_in1)
    q_rot = rope(q, qpos)
    k_cmp, v_cmp = kv[:, :, 0], kv[:, :, 1]
    k_slc, v_slc = rope(kv[:, :, 2], qpos), kv[:, :, 3]
    k_win, v_win = rope(kv[:, :, 4], qpos), kv[:, :, 5]
    past_cmp = cache_kv[page_table, :, 0:2].reshape(n, past_len, 2, N_KV, HEAD_DIM)
    ck = compress(jnp.concatenate([past_cmp[:, :, 0], k_cmp], axis=1), pe_cmp[0], w_cmp[0])
    cv = compress(jnp.concatenate([past_cmp[:, :, 1], v_cmp], axis=1), pe_cmp[1], w_cmp[1])
    bi = jnp.arange(n)[:, None, None, None]
    gi = jnp.arange(N_KV)[None, :, None, None]

    def fetch(kpos):
        pc = jnp.clip(kpos, 0, past_len - 1)
        phys = page_table[bi, pc // PAGE_SIZE]
        off = pc % PAGE_SIZE
        kp = cache_kv[phys, off, 2, gi]
        vp = cache_kv[phys, off, 3, gi]
        pn = jnp.clip(kpos - past_len, 0, s_len - 1)
        is_past = (kpos < past_len)[..., None]
        return jnp.where(is_past, kp, k_slc[bi, pn, gi]), jnp.where(is_past, vp, v_slc[bi, pn, gi])

    wk = jnp.concatenate([cache_win[:, :, 0], k_win], axis=1)
    wv = jnp.concatenate([cache_win[:, :, 1], v_win], axis=1)
    wpos = jnp.concatenate([past_len - wb + jnp.arange(wb), qpos])
    o = nsa_core(q, q_rot, qpos, ck, cv, fetch, wk, wv, wpos, gates, past_len + s_len)
    y = o @ w_out1
    kv_rows = jnp.stack([k_cmp, v_cmp, k_slc, v_slc], axis=2)
    win_rows = jnp.stack([k_win, v_win], axis=2)
    return y, kv_rows, win_rows


def setup_inputs(seed: int = 0) -> dict:
    key = jax.random.key(seed)
    ks = jax.random.split(key, 24)
    f32 = jnp.float32

    def nrm(k, shape, scale):
        return jax.random.normal(k, shape, f32) * scale

    n_pages = PAST_LEN // PAGE_SIZE
    n_used = DEC_BATCH * n_pages
    n_phys = n_used + max(1, n_used // 4)
    page_table = jax.random.permutation(ks[0], n_phys)[:n_used].reshape(DEC_BATCH, n_pages).astype(jnp.int32)
    win_buf = min(WINDOW, PAST_LEN)
    in1_cols = N_HEADS * HEAD_DIM + 6 * N_KV * HEAD_DIM + 3 * N_HEADS
    return {
        "x_prompt": nrm(ks[1], (BATCH, SEQ, D_MODEL), 1.0),
        "x_sample": nrm(ks[2], (DEC_BATCH, DEC_SEQ, D_MODEL), 1.0),
        "state_conv": nrm(ks[3], (DEC_BATCH, CONV_W - 1, D_CONV), 1.0),
        "cache_kv": nrm(ks[4], (n_phys, PAGE_SIZE, 4, N_KV, HEAD_DIM), 1.0),
        "cache_win": nrm(ks[5], (DEC_BATCH, win_buf, 2, N_KV, HEAD_DIM), 1.0),
        "page_table": page_table,
        "norm_mix": 1.0 + nrm(ks[6], (DEPTH, D_MODEL), 0.05),
        "norm_ffn": 1.0 + nrm(ks[7], (DEPTH, D_MODEL), 0.05),
        "norm_final": 1.0 + nrm(ks[8], (D_MODEL,), 0.05),
        "w_in0": nrm(ks[9], (D_MODEL, 3 * D_CONV + 2 * D_CHUNK), D_MODEL ** -0.5),
        "conv_w": nrm(ks[10], (CONV_W, D_CONV), CONV_W ** -0.5),
        "norm_v": 1.0 + nrm(ks[11], (D_CHUNK,), 0.05),
        "w_spatial": nrm(ks[12], (N_CHUNK_HEADS, CHUNK, CHUNK), CHUNK ** -0.5),
        "b_spatial": 1.0 + nrm(ks[13], (N_CHUNK_HEADS, CHUNK), 0.1),
        "w_out0": nrm(ks[14], (D_CONV + D_CHUNK, D_MODEL), (D_CONV + D_CHUNK) ** -0.5),
        "w_in1": nrm(ks[15], (D_MODEL, in1_cols), D_MODEL ** -0.5),
        "pe_cmp": nrm(ks[16], (2, CMP_BLOCK, HEAD_DIM), 0.1),
        "w_cmp": nrm(ks[17], (2, CMP_BLOCK, HEAD_DIM, HEAD_DIM), (CMP_BLOCK * HEAD_DIM) ** -0.5),
        "w_out1": nrm(ks[18], (N_HEADS * HEAD_DIM, D_MODEL), (N_HEADS * HEAD_DIM) ** -0.5),
        "w_ffn_in": nrm(ks[19], (DEPTH, D_MODEL, 2 * D_FF), D_MODEL ** -0.5),
        "w_ffn_out": nrm(ks[20], (DEPTH, D_FF, D_MODEL), D_FF ** -0.5),
    }


def reference(x_prompt, x_sample, state_conv, cache_kv, cache_win, page_table,
              norm_mix, norm_ffn, norm_final, w_in0, conv_w, norm_v, w_spatial, b_spatial, w_out0,
              w_in1, pe_cmp, w_cmp, w_out1, w_ffn_in, w_ffn_out):
    xp, xs = x_prompt, x_sample
    for layer in range(DEPTH):
        hp = rmsnorm(xp, norm_mix[layer])
        hs = rmsnorm(xs, norm_mix[layer])
        if layer % 2 == 0:
            zero_hist = jnp.zeros((xp.shape[0], CONV_W - 1, D_CONV), xp.dtype)
            yp, conv_state_prompt, _ = conv_chunk_mixer(
                hp, zero_hist, w_in0, conv_w, norm_v, w_spatial, b_spatial, w_out0)
            ys, conv_state_sample, chunk_v_sample = conv_chunk_mixer(
                hs, state_conv, w_in0, conv_w, norm_v, w_spatial, b_spatial, w_out0)
        else:
            yp, kv_prompt, win_prompt = nsa_prompt(hp, w_in1, pe_cmp, w_cmp, w_out1)
            ys, kv_sample, win_sample = nsa_sample(
                hs, cache_kv, cache_win, page_table, w_in1, pe_cmp, w_cmp, w_out1)
        xp = xp + yp
        xs = xs + ys
        xp = xp + swiglu(rmsnorm(xp, norm_ffn[layer]), w_ffn_in[layer], w_ffn_out[layer])
        xs = xs + swiglu(rmsnorm(xs, norm_ffn[layer]), w_ffn_in[layer], w_ffn_out[layer])
    y_prompt = rmsnorm(xp, norm_final)
    y_sample = rmsnorm(xs, norm_final)
    return (y_prompt, y_sample, conv_state_prompt, conv_state_sample, chunk_v_sample,
            kv_prompt, kv_sample, win_prompt, win_sample)
```

```cpp
#include <hip/hip_runtime.h>
#include <cstdio>
#include <cstdint>
#include <cmath>
namespace pg8 {
#define PG8_LAS __attribute__((address_space(3)))
typedef unsigned short bf16_t;
typedef short bf16x8 __attribute__((ext_vector_type(8)));
typedef float f32x4 __attribute__((ext_vector_type(4)));
typedef unsigned u32x4 __attribute__((ext_vector_type(4)));
constexpr int BM = 256, BK = 64, HALF = 128, HTB = HALF * BK * 2  , STAGE_BYTES = 8 * HTB, NXCD = 8, WGM = 8;

__host__ __device__ __forceinline__ int lds_byte(int r, int c) { const int st = (r >> 4) * 2 + (c >> 5), rr = r & 15, cc = c & 31, ob = rr * 64 + cc * 2; return st * 1024 + (ob ^ (((ob >> 9) & 1) << 5)); }
__host__ __device__ __forceinline__ void stage_rc(int b, int& R, int& C) { const int st = b / 1024, sb = b % 1024, swz = sb ^ (((sb >> 9) & 1) << 5); R = (st >> 1) * 16 + swz / 64; C = (st & 1) * 32 + (swz % 64) / 2; }
__host__ __device__ __forceinline__ int perm32(int rho) { const int n = rho >> 4, i = rho & 15; return 8 * (i >> 2) + 4 * n + (i & 3); }

struct Unit { int pm, pn; };
struct Gemm { const bf16_t* A; const bf16_t* Bt; int M, N, K; };

struct StaticOrder {
    int nM, nN, nwg, G, c;
    __host__ __device__ void init(int M, int N, int G_, int c_) { nM = M / BM; nN = N / BM; nwg = nM * nN; G = G_; c = c_; }
    __host__ __device__ bool next(int i, Unit& u) const {
        const long L = (long)i * G + c; if (L >= nwg) return false;
        int wgid = (int)L; { const int q = nwg / NXCD, r = nwg % NXCD, xcd = wgid % NXCD, off = wgid / NXCD; wgid = (xcd < r ? xcd * (q + 1) : r * (q + 1) + (xcd - r) * q) + off; }
        const int nig = WGM * nN, gid = wgid / nig, fm = gid * WGM, gsz = (nM - fm) < WGM ? (nM - fm) : WGM;
        u.pm = fm + ((wgid % nig) % gsz); u.pn = (wgid % nig) / gsz; return true;
    }
    __device__ __forceinline__ void a_ready(const Unit&) const {}
    __device__ __forceinline__ void done(const Unit&) const {}
};

constexpr int ROWS_REAL = 16512, ROWS_PROMPT = 16384;
__device__ __forceinline__ unsigned cvt_pk_bf16(float lo, float hi) { unsigned r; asm volatile("v_cvt_pk_bf16_f32 %0, %1, %2" : "=v"(r) : "v"(lo), "v"(hi)); return r; }
__device__ __forceinline__ void st16_wt(void* p, u32x4 v) { asm volatile("global_store_dwordx4 %0, %1, off sc1\n\ts_nop 1" :: "v"(p), "v"(v) : "memory"); }
__device__ __forceinline__ void st16f_wt(void* p, f32x4 v) { asm volatile("global_store_dwordx4 %0, %1, off sc1\n\ts_nop 1" :: "v"(p), "v"(v) : "memory"); }
typedef unsigned u32x2w __attribute__((ext_vector_type(2)));
__device__ __forceinline__ void st8_wt(void* p, u32x2w v) { asm volatile("global_store_dwordx2 %0, %1, off sc1" :: "v"(p), "v"(v) : "memory"); }
__device__ __forceinline__ float row_rs(const float* SS, int row) {
    const f32x4* p = (const f32x4*)(SS + (size_t)row * 16);
    const f32x4 a = p[0], b = p[1], c = p[2], d = p[3];
    const float s = ((a[0] + a[1]) + (a[2] + a[3])) + ((b[0] + b[1]) + (b[2] + b[3])) + ((c[0] + c[1]) + (c[2] + c[3])) + ((d[0] + d[1]) + (d[2] + d[3]));
    return 1.0f / sqrtf(s * (1.0f / 1024.0f) + 1e-6f);
}
__device__ __forceinline__ void wave_row_rs(const float* SS, int base, int fr, int fq, float (&rs)[2][4]) {
    const int L = fq * 16 + fr; float mine[2]; f32x4 p[2][4];
#pragma unroll
    for (int ai = 0; ai < 2; ++ai) { const f32x4* q = (const f32x4*)(SS + (size_t)(base + ai * HALF + L) * 16);
#pragma unroll
        for (int j = 0; j < 4; ++j) p[ai][j] = q[j]; }
#pragma unroll
    for (int ai = 0; ai < 2; ++ai) { const f32x4 a = p[ai][0], b = p[ai][1], c = p[ai][2], d = p[ai][3];
        const float s = ((a[0] + a[1]) + (a[2] + a[3])) + ((b[0] + b[1]) + (b[2] + b[3])) + ((c[0] + c[1]) + (c[2] + c[3])) + ((d[0] + d[1]) + (d[2] + d[3]));
        mine[ai] = 1.0f / sqrtf(s * (1.0f / 1024.0f) + 1e-6f); }
#pragma unroll
    for (int ai = 0; ai < 2; ++ai)
#pragma unroll
        for (int m = 0; m < 4; ++m) rs[ai][m] = __int_as_float(__builtin_amdgcn_ds_bpermute((m * 16 + fr) * 4, __float_as_int(mine[ai])));
}
__device__ __forceinline__ float gelu_tanh(float x) { const float y = 0.7978845608028654f * (x + 0.044715f * x * x * x); return x * __builtin_amdgcn_rcpf(1.0f + __builtin_amdgcn_exp2f(-2.0f * 1.4426950408889634f * y)); }
struct EpiScaleBf16 {
    static constexpr bool PERM = true, AFTER_DRAIN = false;
    bf16_t* O; int ldc; const float* SS; float* VSS;
    __device__ __forceinline__ void operator()(const f32x4 (&acc)[2][2][4][2], const Unit& u, int wr, int wc, int fr, int fq) const {
        const int row0 = u.pm * BM + wr * 64 + fr, col0 = u.pn * BM + wc * 32 + 8 * fq;
        float rsv[2][4]; wave_row_rs(SS, u.pm * BM + wr * 64, fr, fq, rsv);
#pragma unroll
        for (int ai = 0; ai < 2; ++ai)
#pragma unroll
            for (int m = 0; m < 4; ++m) { const int row = row0 + ai * HALF + m * 16; const float rs = rsv[ai][m]; bf16_t* rowp = O + (size_t)row * ldc + col0;
                float gs = 0.f;
#pragma unroll
                for (int bj = 0; bj < 2; ++bj) { const f32x4 v0 = acc[ai][bj][m][0] * rs, v1 = acc[ai][bj][m][1] * rs;
                    u32x4 w; w.x = cvt_pk_bf16(v0[0], v0[1]); w.y = cvt_pk_bf16(v0[2], v0[3]); w.z = cvt_pk_bf16(v1[0], v1[1]); w.w = cvt_pk_bf16(v1[2], v1[3]);
                    *(u32x4*)(rowp + bj * HALF) = w;
                    if (VSS && u.pn >= 8) {
#pragma unroll
                        for (int i = 0; i < 4; ++i) { const float g0 = gelu_tanh(v0[i]), g1 = gelu_tanh(v1[i]); gs += g0 * g0 + g1 * g1; } } }
                if (VSS && u.pn >= 8) {
                    gs += __int_as_float(__builtin_amdgcn_ds_swizzle(__float_as_int(gs), 0x1F | (16 << 10)));
                    { auto rr = __builtin_amdgcn_permlane32_swap(__float_as_uint(gs), __float_as_uint(gs), false, false); gs = __uint_as_float(rr[0]) + __uint_as_float(rr[1]); }
                    if (fq == 0) VSS[(size_t)row * 8 + (u.pn - 8) * 4 + wc] = gs; } }
    }
};
struct EpiSwiGLU {
    static constexpr bool PERM = true, AFTER_DRAIN = false;
    bf16_t* O; int ldc; const float* SS;
    __device__ __forceinline__ void operator()(const f32x4 (&acc)[2][2][4][2], const Unit& u, int wr, int wc, int fr, int fq) const {
        const int row0 = u.pm * BM + wr * 64 + fr, col0 = u.pn * HALF + wc * 32 + 8 * fq;
        float rsv[2][4]; wave_row_rs(SS, u.pm * BM + wr * 64, fr, fq, rsv);
#pragma unroll
        for (int ai = 0; ai < 2; ++ai)
#pragma unroll
            for (int m = 0; m < 4; ++m) { const int row = row0 + ai * HALF + m * 16; const float rs = rsv[ai][m];
                float o[8];
#pragma unroll
                for (int n = 0; n < 2; ++n)
#pragma unroll
                    for (int i = 0; i < 4; ++i) { const float a = acc[ai][0][m][n][i] * rs, b = acc[ai][1][m][n][i] * rs;
                        const float e = __builtin_amdgcn_exp2f(-1.4426950408889634f * a); o[n * 4 + i] = a * __builtin_amdgcn_rcpf(1.0f + e) * b; }
                u32x4 w; w.x = cvt_pk_bf16(o[0], o[1]); w.y = cvt_pk_bf16(o[2], o[3]); w.z = cvt_pk_bf16(o[4], o[5]); w.w = cvt_pk_bf16(o[6], o[7]);
                *(u32x4*)(O + (size_t)row * ldc + col0) = w; }
    }
};
template <bool FIRST> struct EpiResid {
    static_assert(!FIRST, "the residual source is the bf16 stream");
    static constexpr bool PERM = true, AFTER_DRAIN = false;
    const float* xp; const float* xs; bf16_t* XB; float* SS;
    __device__ __forceinline__ void operator()(const f32x4 (&acc)[2][2][4][2], const Unit& u, int wr, int wc, int fr, int fq) const {
        const int row0 = u.pm * BM + wr * 64 + fr, col0 = u.pn * BM + wc * 32 + 8 * fq;
        bf16_t* base = XB + (size_t)row0 * 1024 + col0;
        u32x4 res[2][4][2];
#pragma unroll
        for (int ai = 0; ai < 2; ++ai)
#pragma unroll
            for (int m = 0; m < 4; ++m)
#pragma unroll
                for (int bj = 0; bj < 2; ++bj) res[ai][m][bj] = *(const u32x4*)(base + (size_t)(ai * HALF + m * 16) * 1024 + bj * HALF);
        __builtin_amdgcn_sched_barrier(0);
#pragma unroll
        for (int ai = 0; ai < 2; ++ai)
#pragma unroll
            for (int m = 0; m < 4; ++m) { const int row = row0 + ai * HALF + m * 16;
                float sq = 0.f;
#pragma unroll
                for (int bj = 0; bj < 2; ++bj) { const u32x4 o = res[ai][m][bj];
                    const f32x4 x0 = (f32x4){__uint_as_float(o.x << 16), __uint_as_float(o.x & 0xffff0000u), __uint_as_float(o.y << 16), __uint_as_float(o.y & 0xffff0000u)} + acc[ai][bj][m][0];
                    const f32x4 x1 = (f32x4){__uint_as_float(o.z << 16), __uint_as_float(o.z & 0xffff0000u), __uint_as_float(o.w << 16), __uint_as_float(o.w & 0xffff0000u)} + acc[ai][bj][m][1];
                    u32x4 w; w.x = cvt_pk_bf16(x0[0], x0[1]); w.y = cvt_pk_bf16(x0[2], x0[3]); w.z = cvt_pk_bf16(x1[0], x1[1]); w.w = cvt_pk_bf16(x1[2], x1[3]);
                    *(u32x4*)(base + (size_t)(ai * HALF + m * 16) * 1024 + bj * HALF) = w;
                    sq += ((x0[0] * x0[0] + x0[1] * x0[1]) + (x0[2] * x0[2] + x0[3] * x0[3])) + ((x1[0] * x1[0] + x1[1] * x1[1]) + (x1[2] * x1[2] + x1[3] * x1[3])); }
                sq += __int_as_float(__builtin_amdgcn_ds_swizzle(__float_as_int(sq), 0x1F | (16 << 10)));
                { auto rr = __builtin_amdgcn_permlane32_swap(__float_as_uint(sq), __float_as_uint(sq), false, false); sq = __uint_as_float(rr[0]) + __uint_as_float(rr[1]); }
                if (fq == 0) SS[(size_t)row * 16 + u.pn * 4 + wc] = sq; }
    }
};
struct EpiF32 {
    static constexpr bool PERM = false, AFTER_DRAIN = false;
    float* O; int ldc; const float* SS;
    __device__ __forceinline__ void operator()(const f32x4 (&acc)[2][2][4][2], const Unit& u, int wr, int wc, int fr, int fq) const {
        const int row0 = u.pm * BM + wr * 64 + fr, col0 = u.pn * BM + wc * 32 + 4 * fq;
#pragma unroll
        for (int ai = 0; ai < 2; ++ai)
#pragma unroll
            for (int m = 0; m < 4; ++m) { const int row = row0 + ai * HALF + m * 16; const float rs = SS ? row_rs(SS, row) : 1.0f; float* rowp = O + (size_t)row * ldc + col0;
#pragma unroll
                for (int bj = 0; bj < 2; ++bj)
#pragma unroll
                    for (int n = 0; n < 2; ++n) *(f32x4*)(rowp + bj * HALF + n * 16) = acc[ai][bj][m][n] * rs; }
    }
};

struct EpiNsa {
    static constexpr bool PERM = false, AFTER_DRAIN = false;
    const float* SS; bf16_t *Q, *QR, *KVB; float *G, *out; size_t off_kvp, off_kvs, off_winp, off_wins, kvb_ty; float c2;
    __device__ __forceinline__ void operator()(const f32x4 (&acc)[2][2][4][2], const Unit& u, int wr, int wc, int fr, int fq) const {
        typedef unsigned u32x2v __attribute__((ext_vector_type(2)));
        const int pn = u.pn, row0 = u.pm * BM + wr * 64 + fr, d0 = 16 * (wc & 1) + 4 * fq;
        const bool rope_tile = pn < 4 || pn == 6 || pn == 8;
        f32x4 invf;
#pragma unroll
        for (int i = 0; i < 4; ++i) invf[i] = __builtin_amdgcn_exp2f(-(float)(d0 + i) * 0.41524101186092029f) * 0.15915494309189535f;
        float rsv[2][4]; wave_row_rs(SS, u.pm * BM + wr * 64, fr, fq, rsv);
#pragma unroll
        for (int ai = 0; ai < 2; ++ai)
#pragma unroll
            for (int m = 0; m < 4; ++m) { const int row = row0 + ai * HALF + m * 16;
                if (row < ROWS_REAL) {
                    const float rs = rsv[ai][m]; const bool smp = row >= ROWS_PROMPT; const int pos = smp ? 2048 : (row & 4095); const int nseq = row >> 12;
                    f32x4 cs = (f32x4){1.f, 1.f, 1.f, 1.f}, sn = (f32x4){0.f, 0.f, 0.f, 0.f};
                    if (rope_tile) {
#pragma unroll
                        for (int i = 0; i < 4; ++i) { float rev = (float)pos * invf[i]; rev -= floorf(rev); sn[i] = __builtin_amdgcn_sinf(rev); cs[i] = __builtin_amdgcn_cosf(rev); } }
#pragma unroll
                    for (int bj = 0; bj < 2; ++bj) { const int hb = 2 * bj + (wc >> 1); const f32x4 lo = acc[ai][bj][m][0] * rs, hi = acc[ai][bj][m][1] * rs;
                        if (pn < 4) { const size_t o = (size_t)row * 1024 + (4 * pn + hb) * 64 + d0; const f32x4 ql = lo * c2, qh = hi * c2;
                            u32x2v w; w.x = cvt_pk_bf16(ql[0], ql[1]); w.y = cvt_pk_bf16(ql[2], ql[3]); *(u32x2v*)(Q + o) = w; w.x = cvt_pk_bf16(qh[0], qh[1]); w.y = cvt_pk_bf16(qh[2], qh[3]); *(u32x2v*)(Q + o + 32) = w;
                            const f32x4 rl = ql * cs - qh * sn, rh = qh * cs + ql * sn;
                            w.x = cvt_pk_bf16(rl[0], rl[1]); w.y = cvt_pk_bf16(rl[2], rl[3]); *(u32x2v*)(QR + o) = w; w.x = cvt_pk_bf16(rh[0], rh[1]); w.y = cvt_pk_bf16(rh[2], rh[3]); *(u32x2v*)(QR + o + 32) = w; }
                        else if (pn < 10) { const int ty = pn - 4, g = hb; f32x4 vl = lo, vh = hi;
                            if (rope_tile) { vl = lo * cs - hi * sn; vh = hi * cs + lo * sn; }
                            if (ty < 4) { float* op = out + (smp ? off_kvs + (size_t)(row - ROWS_PROMPT) * 1024 : off_kvp + (size_t)row * 1024) + ty * 256 + g * 64 + d0; *(f32x4*)op = vl; *(f32x4*)(op + 32) = vh; }
                            else if (smp) { float* op = out + off_wins + (size_t)(row - ROWS_PROMPT) * 512 + (ty - 4) * 256 + g * 64 + d0; *(f32x4*)op = vl; *(f32x4*)(op + 32) = vh; }
                            else if (pos >= 4096 - 512) { float* op = out + off_winp + ((size_t)nseq * 512 + (pos - (4096 - 512))) * 512 + (ty - 4) * 256 + g * 64 + d0; *(f32x4*)op = vl; *(f32x4*)(op + 32) = vh; }
                            if (!smp) { bf16_t* kp = KVB + (size_t)ty * kvb_ty + (((size_t)nseq * 4 + g) * 4096 + pos) * 64 + d0;
                                u32x2v w; w.x = cvt_pk_bf16(vl[0], vl[1]); w.y = cvt_pk_bf16(vl[2], vl[3]); *(u32x2v*)kp = w; w.x = cvt_pk_bf16(vh[0], vh[1]); w.y = cvt_pk_bf16(vh[2], vh[3]); *(u32x2v*)(kp + 32) = w; } }
                        else {
#pragma unroll
                            for (int n = 0; n < 2; ++n) { const int j = 128 * bj + 32 * wc + 16 * n + 4 * fq;
                                if (j < 48) { const f32x4 v = acc[ai][bj][m][n] * rs; f32x4 sg;
#pragma unroll
                                    for (int i = 0; i < 4; ++i) sg[i] = __builtin_amdgcn_rcpf(1.0f + __builtin_amdgcn_exp2f(-1.4426950408889634f * v[i]));
                                    *(f32x4*)(G + (size_t)row * 48 + j) = sg; } } }
                    } } }
    }
};

template <class Epi, class Sched, bool ALIGN_EPI = false, bool SP2 = false>
__device__ __forceinline__ void gemm_phase(PG8_LAS unsigned char* lds, const Gemm g, const Sched& S, const Epi& E, const int tid_in) {
    int tid_ = tid_in; asm volatile("" : "+v"(tid_));
    const int tid = tid_, wid = __builtin_amdgcn_readfirstlane(tid >> 6), lane = tid & 63, wr = wid >> 2, wc = wid & 3, fr = lane & 15, fq = lane >> 4;
    const int K = g.K, nt = K / BK;
    unsigned voffA[2], voffB[2];
#pragma unroll
    for (int i = 0; i < 2; ++i) { int R, C; stage_rc(tid * 16 + i * 8192, R, C); const int Rb = Epi::PERM ? ((R & ~31) + perm32(R & 31)) : R;
        voffA[i] = (unsigned)(R * K + C) * 2u; voffB[i] = (unsigned)(Rb * K + C) * 2u; }
    const size_t kstep = (size_t)(BK * 2);
    const size_t hstep = (size_t)HALF * K * 2;
    const size_t tstep = 2 * hstep;
    const unsigned ldsw = (unsigned)wid * 1024u;
    const int aoff = lds_byte(wr * 64 + fr, fq * 8), boff = lds_byte(wc * 32 + fr, fq * 8);
#define PG8_SA(b, h) (((b) * 2 + (h)) * HTB)
#define PG8_SB(b, h) ((4 + (b) * 2 + (h)) * HTB)
#define PG8_STAGE(bufoff, gbase, voff) do { _Pragma("unroll") for (int _i = 0; _i < 2; ++_i) \
        __builtin_amdgcn_global_load_lds((const unsigned*)((const char*)(gbase) + (voff)[_i]), (PG8_LAS unsigned*)(lds + (bufoff) + ldsw + _i * 8192), 16, 0, 0); } while (0)
#define PG8_LDA(dst, b, h) do { _Pragma("unroll") for (int m = 0; m < 4; ++m) _Pragma("unroll") for (int k = 0; k < 2; ++k) dst[m][k] = *(const PG8_LAS bf16x8*)(lds + PG8_SA(b, h) + aoff + m * 2048 + k * 1024); } while (0)
#define PG8_LDB(dst, b, h) do { _Pragma("unroll") for (int n = 0; n < 2; ++n) _Pragma("unroll") for (int k = 0; k < 2; ++k) dst[n][k] = *(const PG8_LAS bf16x8*)(lds + PG8_SB(b, h) + boff + n * 2048 + k * 1024); } while (0)
#define PG8_MMA(ai, bj, At, Bt) do { __builtin_amdgcn_s_setprio(1); _Pragma("unroll") for (int m = 0; m < 4; ++m) _Pragma("unroll") for (int n = 0; n < 2; ++n) _Pragma("unroll") for (int k = 0; k < 2; ++k) \
        acc[ai][bj][m][n] = __builtin_amdgcn_mfma_f32_16x16x32_bf16(Bt[n][k], At[m][k], acc[ai][bj][m][n], 0, 0, 0); __builtin_amdgcn_s_setprio(0); } while (0)
#define PG8_WAIT_V(n) asm volatile("s_waitcnt vmcnt(" #n ")" ::: "memory")
#define PG8_WAIT_L(n) asm volatile("s_waitcnt lgkmcnt(" #n ")" ::: "memory")
#define PG8_BAR __builtin_amdgcn_s_barrier()
#define PG8_SCHED __builtin_amdgcn_sched_barrier(0)
    Unit cur, nxt; int ui = 0;
    if (!S.next(0, cur)) return;
    f32x4 acc[2][2][4][2];
#pragma unroll
    for (int a = 0; a < 2; ++a)
#pragma unroll
        for (int b = 0; b < 2; ++b)
#pragma unroll
            for (int m = 0; m < 4; ++m)
#pragma unroll
                for (int n = 0; n < 2; ++n) acc[a][b][m][n] = (f32x4){0.f, 0.f, 0.f, 0.f};
    bf16x8 At[4][2], B0[2][2], B1[2][2];
    const char* cA = (const char*)g.A + (size_t)cur.pm * tstep; const char* cB = (const char*)g.Bt + (size_t)cur.pn * tstep;
    S.a_ready(cur);
    if constexpr (SP2) {
        PG8_STAGE(PG8_SB(0, 0), cB, voffB); PG8_STAGE(PG8_SB(0, 1), cB + hstep, voffB); PG8_STAGE(PG8_SA(0, 0), cA, voffA); PG8_STAGE(PG8_SA(0, 1), cA + hstep, voffA);
        if (wr == 1) PG8_BAR;
        PG8_WAIT_V(2); PG8_BAR;
        PG8_STAGE(PG8_SB(1, 0), cB + kstep, voffB); PG8_STAGE(PG8_SA(1, 0), cA + kstep, voffA); PG8_STAGE(PG8_SB(1, 1), cB + hstep + kstep, voffB);
        PG8_WAIT_V(6); PG8_BAR;
    } else {
        PG8_STAGE(PG8_SB(0, 0), cB, voffB); PG8_STAGE(PG8_SA(0, 0), cA, voffA); PG8_STAGE(PG8_SB(0, 1), cB + hstep, voffB); PG8_STAGE(PG8_SA(0, 1), cA + hstep, voffA);
        if (wr == 1) PG8_BAR;
        PG8_WAIT_V(4); PG8_BAR;
        PG8_STAGE(PG8_SB(1, 0), cB + kstep, voffB); PG8_STAGE(PG8_SA(1, 0), cA + kstep, voffA); PG8_STAGE(PG8_SB(1, 1), cB + hstep + kstep, voffB);
        PG8_WAIT_V(6); PG8_BAR;
    }
    for (;;) {
        const bool has_next = S.next(ui + 1, nxt);
        const char* nA = has_next ? (const char*)g.A + (size_t)nxt.pm * tstep : cA; const char* nB = has_next ? (const char*)g.Bt + (size_t)nxt.pn * tstep : cB;
        for (int t = 0; t < nt; t += 2) {
            const bool last = (t == nt - 2);
            const char* a1 = cA + (size_t)(t + 1) * kstep;
            const char* a2 = last ? nA : cA + (size_t)(t + 2) * kstep; const char* b2 = last ? nB : cB + (size_t)(t + 2) * kstep;
            const char* a3 = a2 + kstep; const char* b3 = b2 + kstep;
            if (last && has_next) S.a_ready(nxt);
            if constexpr (SP2) {
            PG8_LDB(B0, 0, 0); PG8_LDB(B1, 0, 1); PG8_SCHED; PG8_LDA(At, 0, 0); PG8_STAGE(PG8_SA(1, 1), a1 + hstep, voffA);
            PG8_WAIT_V(8); PG8_WAIT_L(0); PG8_BAR; PG8_MMA(0, 0, At, B0); PG8_MMA(0, 1, At, B1); PG8_BAR; PG8_SCHED;
            PG8_LDA(At, 0, 1); PG8_STAGE(PG8_SB(0, 0), b2, voffB); PG8_STAGE(PG8_SB(0, 1), b2 + hstep, voffB); PG8_STAGE(PG8_SA(0, 0), a2, voffA);
            PG8_WAIT_V(8); PG8_WAIT_L(0); PG8_BAR; PG8_MMA(1, 0, At, B0); PG8_MMA(1, 1, At, B1); PG8_BAR; PG8_SCHED;
            PG8_LDB(B0, 1, 0); PG8_LDB(B1, 1, 1); PG8_SCHED; PG8_LDA(At, 1, 0); PG8_STAGE(PG8_SA(0, 1), a2 + hstep, voffA);
            PG8_WAIT_V(8); PG8_WAIT_L(0); PG8_BAR; PG8_MMA(0, 0, At, B0); PG8_MMA(0, 1, At, B1); PG8_BAR; PG8_SCHED;
            PG8_LDA(At, 1, 1); PG8_STAGE(PG8_SB(1, 0), b3, voffB); PG8_STAGE(PG8_SB(1, 1), b3 + hstep, voffB); PG8_STAGE(PG8_SA(1, 0), a3, voffA);
            PG8_WAIT_V(8); PG8_WAIT_L(0); PG8_BAR; PG8_MMA(1, 0, At, B0); PG8_MMA(1, 1, At, B1); PG8_BAR; PG8_SCHED;
            } else {
            PG8_LDB(B0, 0, 0); PG8_SCHED; PG8_LDA(At, 0, 0); PG8_STAGE(PG8_SA(1, 1), a1 + hstep, voffA);
            PG8_WAIT_L(8); PG8_BAR; PG8_WAIT_L(0); PG8_MMA(0, 0, At, B0); PG8_BAR; PG8_SCHED;
            PG8_LDB(B1, 0, 1); PG8_STAGE(PG8_SB(0, 0), b2, voffB);
            PG8_BAR; PG8_WAIT_L(0); PG8_MMA(0, 1, At, B1); PG8_BAR;
            PG8_LDA(At, 0, 1); PG8_STAGE(PG8_SA(0, 0), a2, voffA);
            PG8_BAR; PG8_WAIT_L(0); PG8_MMA(1, 0, At, B0); PG8_BAR; PG8_SCHED;
            PG8_STAGE(PG8_SB(0, 1), b2 + hstep, voffB);
            PG8_WAIT_V(6); PG8_BAR; PG8_MMA(1, 1, At, B1); PG8_BAR;
            PG8_LDB(B0, 1, 0); PG8_SCHED; PG8_LDA(At, 1, 0); PG8_STAGE(PG8_SA(0, 1), a2 + hstep, voffA);
            PG8_WAIT_L(8); PG8_BAR; PG8_WAIT_L(0); PG8_MMA(0, 0, At, B0); PG8_BAR; PG8_SCHED;
            PG8_LDB(B1, 1, 1); PG8_STAGE(PG8_SB(1, 0), b3, voffB);
            PG8_BAR; PG8_WAIT_L(0); PG8_MMA(0, 1, At, B1); PG8_BAR;
            PG8_LDA(At, 1, 1); PG8_STAGE(PG8_SA(1, 0), a3, voffA);
            PG8_BAR; PG8_WAIT_L(0); PG8_MMA(1, 0, At, B0); PG8_BAR; PG8_SCHED;
            PG8_STAGE(PG8_SB(1, 1), b3 + hstep, voffB);
            PG8_WAIT_V(6); PG8_BAR; PG8_MMA(1, 1, At, B1); PG8_BAR;
            }
        }
        if constexpr (ALIGN_EPI) { if (wr == 0) PG8_BAR; }
        if constexpr (!Epi::AFTER_DRAIN) { E(acc, cur, wr, wc, fr, fq); S.done(cur); }
        if (!has_next) break;
#pragma unroll
        for (int a = 0; a < 2; ++a)
#pragma unroll
            for (int b = 0; b < 2; ++b)
#pragma unroll
                for (int m = 0; m < 4; ++m)
#pragma unroll
                    for (int n = 0; n < 2; ++n) acc[a][b][m][n] = (f32x4){0.f, 0.f, 0.f, 0.f};
        cur = nxt; cA = nA; cB = nB; ++ui;
        if constexpr (ALIGN_EPI) { if (wr == 1) PG8_BAR; }
    }
    PG8_WAIT_V(0);
    if constexpr (!ALIGN_EPI) { if (wr == 0) PG8_BAR; }
    PG8_BAR;
    if constexpr (Epi::AFTER_DRAIN) { E.fused(acc, cur, wr, wc, fr, fq, lds, wid, lane); S.done(cur); }
#undef PG8_SA
#undef PG8_SB
#undef PG8_STAGE
#undef PG8_LDA
#undef PG8_LDB
#undef PG8_MMA
#undef PG8_WAIT_V
#undef PG8_WAIT_L
#undef PG8_BAR
#undef PG8_SCHED
}
}

constexpr int NWAVES = 8;
constexpr int D = 1024, SEQ = 4096, NBATCH = 4, NP = NBATCH * SEQ, NSMP = 128, MR = NP + NSMP, MP = 16640;
constexpr int N_IN0 = 2560, DFF = 2816, N_FF2 = 2 * DFF, N_IN1 = 2608, N_IN1P = 2816;
constexpr int PAST = 2048;
constexpr float RMS_EPS = 1e-6f;
constexpr float C2 = 0.125f * 1.4426950408889634f;
static_assert(pg8::ROWS_REAL == MR && pg8::ROWS_PROMPT == NP, "row constants");
constexpr size_t OFF_Y = 0, OFF_YS = 16777216, OFF_CSP = 16908288, OFF_CSS = 16912384, OFF_CVS = 17043456, OFF_KVP = 17108992, OFF_KVS = 33886208, OFF_WINP = 34017280, OFF_WINS = 35065856, OUT_TOTAL = 35131392;
constexpr size_t MiB = 1u << 20, HMiB = 1u << 19;
constexpr size_t WS_CTL = 0, CTL_ZERO_BYTES = 1 * MiB;
constexpr size_t WS_W0IN = 2 * MiB, WS_W0OUT = 7 * MiB, WS_WFI0 = 9 * MiB, WS_WFI1 = 20 * MiB, WS_WFO0 = 31 * MiB, WS_WFO1 = 36 * MiB + HMiB, WS_W1IN = 42 * MiB, WS_W1OUT = 47 * MiB + HMiB, WS_WCMP = 49 * MiB + HMiB;
constexpr size_t WS_SS = 50 * MiB, WS_CBIAS = 52 * MiB, WS_VSS = 52 * MiB + 65536, WS_G = 53 * MiB;
constexpr size_t WS_X = 64 * MiB, WS_XB = 129 * MiB, WS_H0 = 162 * MiB, WS_YC = 244 * MiB, WS_ACT = 277 * MiB, WS_H1 = 367 * MiB, WS_Q = 546 * MiB, WS_QR = 579 * MiB, WS_O = 612 * MiB;
constexpr size_t WS_CMPA = 645 * MiB, WS_KVB = 901 * MiB, WS_PQ = 949 * MiB, WS_END = 1085 * MiB;
constexpr int CMP_ROWS_S = 131072, CMP_ROWS = CMP_ROWS_S + 8192;
constexpr size_t KVB_TY = (size_t)16 * SEQ * 64;
static_assert(WS_CMPA + (size_t)CMP_ROWS_S * 1024 * 2 == WS_KVB, "the prompt k_cmp/v_cmp rows follow the sample rows");
constexpr int CW_TMO = 0, CW_BAR = 4096, CW_FLAG = 16384, CW_QUEUE = 32768;
constexpr int RING_OFF = 0, RING_BYTES = 131072;
constexpr int LDSCTL_OFF = 133120, MISC_OFF = LDSCTL_OFF + 320;
constexpr int LDS_BYTES = 147456;
static_assert(MISC_OFF + 128 <= LDS_BYTES, "LDS map");

#define GAS __attribute__((address_space(1)))
#define LAS __attribute__((address_space(3)))
typedef unsigned short bf16;
typedef unsigned u32x4 __attribute__((ext_vector_type(4)));
typedef unsigned u32x2 __attribute__((ext_vector_type(2)));
typedef float f32x4 __attribute__((ext_vector_type(4)));
typedef float f32x16 __attribute__((ext_vector_type(16)));
typedef short bf16x8 __attribute__((ext_vector_type(8)));
typedef short s16x4 __attribute__((ext_vector_type(4)));
typedef GAS unsigned gu32;
#define RLX_AGENT __ATOMIC_RELAXED, __HIP_MEMORY_SCOPE_AGENT
#define LDS_WAIT() asm volatile("s_waitcnt lgkmcnt(0)" ::: "memory")
#define VM_WAIT() asm volatile("s_waitcnt vmcnt(0)" ::: "memory")
typedef float f32x2_t __attribute__((ext_vector_type(2))); typedef __bf16 bf16x2_t __attribute__((ext_vector_type(2)));
__device__ __forceinline__ unsigned pk2(float lo, float hi) { f32x2_t v = {lo, hi}; bf16x2_t b = __builtin_convertvector(v, bf16x2_t); return __builtin_bit_cast(unsigned, b); }
__device__ __forceinline__ float bflo(unsigned w) { return __uint_as_float(w << 16); }
__device__ __forceinline__ float bfhi(unsigned w) { return __uint_as_float(w & 0xffff0000u); }
__device__ __forceinline__ float bf1(bf16 b) { return __uint_as_float((unsigned)b << 16); }
template <int CTRL> __device__ __forceinline__ float dpp_mov(float v) { return __int_as_float(__builtin_amdgcn_update_dpp(0, __float_as_int(v), CTRL, 0xF, 0xF, true)); }
template <int X> __device__ __forceinline__ float lane_xor(float v) { static_assert(X >= 1 && X < 32, "xor within a 32-lane half");
    if (X == 1) return dpp_mov<0xB1>(v); if (X == 2) return dpp_mov<0x4E>(v);
    return __int_as_float(__builtin_amdgcn_ds_swizzle(__float_as_int(v), 0x1F | (X << 10))); }
__device__ __forceinline__ float sum16(float v) { v += dpp_mov<0xB1>(v); v += dpp_mov<0x4E>(v); v += dpp_mov<0x141>(v); v += dpp_mov<0x140>(v); return v; }
__device__ __forceinline__ float max16(float v) { v = fmaxf(v, dpp_mov<0xB1>(v)); v = fmaxf(v, dpp_mov<0x4E>(v)); v = fmaxf(v, dpp_mov<0x141>(v)); v = fmaxf(v, dpp_mov<0x140>(v)); return v; }
__device__ __forceinline__ float xhalf_sum(float v) { auto rr = __builtin_amdgcn_permlane32_swap(__float_as_uint(v), __float_as_uint(v), false, false); return __uint_as_float(rr[0]) + __uint_as_float(rr[1]); }
__device__ __forceinline__ float xhalf_max(float v) { auto rr = __builtin_amdgcn_permlane32_swap(__float_as_uint(v), __float_as_uint(v), false, false); return fmaxf(__uint_as_float(rr[0]), __uint_as_float(rr[1])); }
__device__ __forceinline__ float xhalf_other(float v, int hh) { auto rr = __builtin_amdgcn_permlane32_swap(__float_as_uint(v), __float_as_uint(v), false, false); return __uint_as_float(hh ? rr[0] : rr[1]); }
__device__ __forceinline__ float wave_sum(float v) { v = sum16(v); v += lane_xor<16>(v); return xhalf_sum(v); }
__device__ __forceinline__ float wave_max(float v) { v = max16(v); v = fmaxf(v, lane_xor<16>(v)); return xhalf_max(v); }
__device__ __forceinline__ int fresh_tid(int wave_s) { int l; asm volatile("v_mbcnt_lo_u32_b32 %0, -1, 0\n\tv_mbcnt_hi_u32_b32 %0, -1, %0" : "=v"(l)); return wave_s * 64 + l; }
__device__ __forceinline__ float gelu_t(float x) {
    const float y = 0.7978845608028654f * (x + 0.044715f * x * x * x);
    const float e = __builtin_amdgcn_exp2f(-2.0f * 1.4426950408889634f * y);
    return x * __builtin_amdgcn_rcpf(1.0f + e);
}
__device__ __forceinline__ float sigmoid_f(float x) { return __builtin_amdgcn_rcpf(1.0f + __builtin_amdgcn_exp2f(-1.4426950408889634f * x)); }
typedef short v4i16_t __attribute__((ext_vector_type(4)));
__device__ __forceinline__ s16x4 tr16(const LAS unsigned char* p) { return __builtin_bit_cast(s16x4, __builtin_amdgcn_ds_read_tr16_b64_v4i16((LAS v4i16_t*)p)); }
__device__ __forceinline__ bf16x8 cat8(s16x4 lo, s16x4 hi) { return (bf16x8){lo[0], lo[1], lo[2], lo[3], hi[0], hi[1], hi[2], hi[3]}; }
__device__ __forceinline__ int crow(int r, int h) { return (r & 3) + 8 * (r >> 2) + 4 * h; }
__device__ __forceinline__ int kappa(int i) { return 16 * ((i >> 2) & 1) + (i & 3) + 4 * (i >> 3); }
__device__ __forceinline__ float max3f(float a, float b, float c) { float r; asm("v_max3_f32 %0, %1, %2, %3" : "=v"(r) : "v"(a), "v"(b), "v"(c)); return r; }
#define MFMA32(a, b, c) __builtin_amdgcn_mfma_f32_32x32x16_bf16((a), (b), (c), 0, 0, 0)

#define XB_TMO      128
#define XB_XCNT(j)  (256  + 64 * (j))
#define XB_XSUB(j)  (1280 + 64 * (j))
#define XB_XGEN(j)  (2304 + 64 * (j))
#define XB_TOP      3328
#define XB_TOPGEN   3392
#define XCD_BAR_WORDS 3456
#define XB_SPIN_CAP (1u << 18)

__device__ __forceinline__ unsigned xb_ld(unsigned* p)              { return __hip_atomic_load(p, __ATOMIC_RELAXED, __HIP_MEMORY_SCOPE_AGENT); }
__device__ __forceinline__ unsigned xb_add(unsigned* p, unsigned v) { return __hip_atomic_fetch_add(p, v, __ATOMIC_RELAXED, __HIP_MEMORY_SCOPE_AGENT); }
__device__ __forceinline__ unsigned xb_xcc_id() { return (unsigned)__builtin_amdgcn_s_getreg((3 << 11) | 20) & 0xFu; }
#define XB_SPIN(cond, bar) do { unsigned _sp = 0; while (cond) { __builtin_amdgcn_s_sleep(1); \
    if ((++_sp & 255u) == 0u) { if (xb_ld(&(bar)[XB_TMO])) break; if (_sp > XB_SPIN_CAP) { atomicAdd(&(bar)[XB_TMO], 1u); break; } } } } while (0)

struct XcdBarrier {
    unsigned* bar; unsigned x;
    volatile LAS unsigned* st;
};

__device__ __forceinline__ XcdBarrier xcd_barrier_post(unsigned* bar, volatile LAS unsigned* st) {
    XcdBarrier b; b.bar = bar; b.x = xb_xcc_id(); b.st = st;
    if (threadIdx.x == 0) (void)xb_add(&bar[XB_XCNT(b.x)], 1u);
    return b;
}
__device__ __forceinline__ void xcd_barrier_complete(unsigned* bar, unsigned x, unsigned& nloc, unsigned& nx) {
    const unsigned G = gridDim.x * gridDim.y * gridDim.z;
    unsigned sum, cnt, mine, sp = 0u;
    for (;;) {
        sum = 0u; cnt = 0u; mine = 0u;
#pragma unroll
        for (unsigned j = 0; j < 16; ++j) { const unsigned c = xb_ld(&bar[XB_XCNT(j)]); sum += c; cnt += (c > 0u) ? 1u : 0u; mine = (j == x) ? c : mine; }
        if (sum == G) break;
        __builtin_amdgcn_s_sleep(1);
        if ((++sp & 255u) == 0u) { if (xb_ld(&bar[XB_TMO])) break; if (sp > XB_SPIN_CAP) { atomicAdd(&bar[XB_TMO], 1u); break; } }
    }
    nloc = mine > 0u ? mine : 1u; nx = cnt > 0u ? cnt : 1u;
}

__device__ __forceinline__ void xcd_barrier(const XcdBarrier& b) {
    asm volatile("s_waitcnt vmcnt(0)" ::: "memory");
    __syncthreads();
    if (threadIdx.x == 0) {
        unsigned* bar = b.bar;
        __builtin_amdgcn_s_waitcnt(0);
        unsigned nloc = b.st[0], nx = b.st[1];
        if (nloc == 0u) { xcd_barrier_complete(bar, b.x, nloc, nx); b.st[0] = nloc; b.st[1] = nx; }
        const unsigned old = xb_add(&bar[XB_XSUB(b.x)], 1u);
        const unsigned gen = old / nloc;
        if (old + 1u == (gen + 1u) * nloc) {
            __builtin_amdgcn_fence(__ATOMIC_RELEASE, "agent");
            asm volatile("s_waitcnt vmcnt(0)" ::: "memory");
            const unsigned og = xb_add(&bar[XB_TOP], 1u);
            const unsigned tg = og / nx;
            if (og + 1u == (tg + 1u) * nx) xb_add(&bar[XB_TOPGEN], 1u);
            else XB_SPIN(xb_ld(&bar[XB_TOPGEN]) == tg, bar);
            __builtin_amdgcn_fence(__ATOMIC_ACQUIRE, "agent");
            xb_add(&bar[XB_XGEN(b.x)], 1u);
            asm volatile("s_waitcnt vmcnt(0)" ::: "memory");
        } else {
            XB_SPIN(xb_ld(&bar[XB_XGEN(b.x)]) == gen, bar);
            __builtin_amdgcn_fence(__ATOMIC_ACQUIRE, "agent");
            asm volatile("s_waitcnt vmcnt(0)" ::: "memory");
        }
    }
    __syncthreads();
}

struct TrItem { const float* W; const float* g; bf16* WT; int ldw, k0, n0, nvalid, K, drow0, drow1; };
struct P0Args { const float *xp, *xs, *norm_mix, *norm_ffn, *w_in0, *w_out0, *w_in1, *pe_cmp, *w_cmp, *w_out1, *w_ffn_in, *w_ffn_out; unsigned char* ws; };
constexpr int TR_IN0 = 16 * 80, TR_OUT = 16 * 32, TR_FI = 16 * 176, TR_FO = 44 * 32, TR_IN1 = 16 * 82, TR_CMP = 128, TR_NITEMS = TR_IN0 + TR_OUT + 2 * TR_FI + 2 * TR_FO + TR_IN1 + TR_OUT + TR_CMP;
__device__ __forceinline__ void tr_decode(const P0Args& a, int r, TrItem& t) {
    unsigned char* ws = a.ws; t.g = nullptr; t.nvalid = 32; t.drow1 = -1;
    if (r < TR_IN0) { t.W = a.w_in0; t.ldw = N_IN0; t.k0 = 64 * (r / 80); t.n0 = 32 * (r % 80); t.WT = (bf16*)(ws + WS_W0IN); t.K = D; t.drow0 = t.n0; t.g = a.norm_mix; }
    else if ((r -= TR_IN0) < TR_OUT) { t.W = a.w_out0; t.ldw = D; t.k0 = 64 * (r / 32); t.n0 = 32 * (r % 32); t.WT = (bf16*)(ws + WS_W0OUT); t.K = D; t.drow0 = t.n0; }
    else if ((r -= TR_OUT) < 2 * TR_FI) { const int l = r / TR_FI; r -= l * TR_FI; const int n0 = 32 * (r % 176); const int nn = n0 < DFF ? n0 : n0 - DFF;
        t.W = a.w_ffn_in + (size_t)l * D * N_FF2; t.ldw = N_FF2; t.k0 = 64 * (r / 176); t.n0 = n0; t.WT = (bf16*)(ws + (l ? WS_WFI1 : WS_WFI0)); t.K = D;
        t.drow0 = 256 * (nn / 128) + (nn % 128) + (n0 < DFF ? 0 : 128); t.g = a.norm_ffn + l * D; }
    else if ((r -= 2 * TR_FI) < 2 * TR_FO) { const int l = r / TR_FO; r -= l * TR_FO;
        t.W = a.w_ffn_out + (size_t)l * DFF * D; t.ldw = D; t.k0 = 64 * (r / 32); t.n0 = 32 * (r % 32); t.WT = (bf16*)(ws + (l ? WS_WFO1 : WS_WFO0)); t.K = DFF; t.drow0 = t.n0; }
    else if ((r -= 2 * TR_FO) < TR_IN1) { const int n0 = 32 * (r % 82);
        const int hb0 = n0 & ~63, d16 = (n0 & 63) >> 4;
        t.W = a.w_in1; t.ldw = N_IN1; t.k0 = 64 * (r / 82); t.n0 = n0; t.nvalid = (N_IN1 - n0) < 32 ? (N_IN1 - n0) : 32; t.WT = (bf16*)(ws + WS_W1IN); t.K = D; t.g = a.norm_mix + D;
        t.drow0 = n0 < 2560 ? hb0 + 32 * (d16 & 1) + 16 * (d16 >> 1) : n0; t.drow1 = n0 < 2560 ? hb0 + 32 * ((d16 + 1) & 1) + 16 * ((d16 + 1) >> 1) : n0 + 16; }
    else if ((r -= TR_IN1) < TR_OUT) { t.W = a.w_out1; t.ldw = D; t.k0 = 64 * (r / 32); t.n0 = 32 * (r % 32); t.WT = (bf16*)(ws + WS_W1OUT); t.K = D; t.drow0 = t.n0; }
    else { r -= TR_OUT; const int th = r >> 5, q = r & 31;
        t.W = a.w_cmp + (size_t)th * 1024 * 64; t.ldw = 64; t.k0 = 64 * (q >> 1); t.n0 = 32 * (q & 1); t.WT = (bf16*)(ws + WS_WCMP); t.K = 1024; t.drow0 = th * 64 + 32 * (q & 1); }
    if (t.drow1 < 0) t.drow1 = t.drow0 + 16;
}
__device__ __forceinline__ void tr_load(const TrItem& t, float (&v)[32], int lane) {
    const int n = lane & 31, kh = lane >> 5; const float* wp = t.W + (size_t)(t.k0 + kh) * t.ldw + t.n0 + (n < t.nvalid ? n : 0);
#pragma unroll
    for (int i = 0; i < 32; ++i) v[i] = wp[(size_t)(2 * i) * t.ldw];
}
__device__ __forceinline__ void tr_finish(const TrItem& t, const float (&v)[32], LAS float* scr, int lane) {
    const int n = lane & 31, kh = lane >> 5;
#pragma unroll
    for (int i = 0; i < 32; ++i) { float x = n < t.nvalid ? v[i] : 0.f; if (t.g) x *= t.g[t.k0 + 2 * i + kh]; scr[(2 * i + kh) * 33 + n] = x; }
    LDS_WAIT(); asm volatile("" ::: "memory");
    const int c = lane & 7;
#pragma unroll
    for (int j = 0; j < 4; ++j) { const int nn = (lane >> 3) + 8 * j; const LAS float* s = scr + (8 * c) * 33 + nn;
        u32x4 o; o.x = pk2(s[0 * 33], s[1 * 33]); o.y = pk2(s[2 * 33], s[3 * 33]); o.z = pk2(s[4 * 33], s[5 * 33]); o.w = pk2(s[6 * 33], s[7 * 33]);
        const int dr = nn < 16 ? t.drow0 + nn : t.drow1 + nn - 16;
        *(u32x4*)(t.WT + (size_t)dr * t.K + t.k0 + 8 * c) = o; }
    LDS_WAIT(); asm volatile("" ::: "memory");
}
constexpr int TRG_N0 = TR_IN0 + TR_FI, TRG_N1 = TR_OUT + TR_FI, TRG_N2 = TR_FO + TR_IN1 + TR_CMP, TRG_N3 = TR_FO + TR_OUT;
static_assert(TRG_N0 + TRG_N1 + TRG_N2 + TRG_N3 == TR_NITEMS, "transpose groups");
__device__ __forceinline__ int tr_group_item(int grp, int j) {
    constexpr int O_OUT0 = TR_IN0, O_FI0 = O_OUT0 + TR_OUT, O_FI1 = O_FI0 + TR_FI, O_FO0 = O_FI1 + TR_FI, O_FO1 = O_FO0 + TR_FO, O_IN1 = O_FO1 + TR_FO, O_OUT1 = O_IN1 + TR_IN1, O_CMP = O_OUT1 + TR_OUT;
    if (grp == 0) return j < TR_IN0 ? j : O_FI1 + (j - TR_IN0);
    if (grp == 1) return O_OUT0 + j;
    if (grp == 2) { if (j < TR_FO) return O_FO0 + j; j -= TR_FO; if (j < TR_IN1) return O_IN1 + j; return O_CMP + (j - TR_IN1); }
    return j < TR_FO ? O_FO1 + j : O_OUT1 + (j - TR_FO);
}
__device__ __forceinline__ void tr_run(const P0Args& a, int grp, int nitems, int wk, int nwk, LAS float* scr, int lane) {
    if (wk < nitems) {
        TrItem A, B; float va[32], vb[32];
        tr_decode(a, tr_group_item(grp, wk), A); tr_load(A, va, lane);
#pragma unroll 1
        for (int it = wk; it < nitems; it += 2 * nwk) {
            const int i1 = it + nwk; const bool h1 = i1 < nitems; tr_decode(a, tr_group_item(grp, h1 ? i1 : it), B); tr_load(B, vb, lane);
            __builtin_amdgcn_sched_barrier(0);
            tr_finish(A, va, scr, lane);
            const int i2 = it + 2 * nwk; const bool h2 = i2 < nitems; tr_decode(a, tr_group_item(grp, h2 ? i2 : it), A); tr_load(A, va, lane);
            __builtin_amdgcn_sched_barrier(0);
            if (h1) tr_finish(B, vb, scr, lane);
        }
    }
}
__device__ __forceinline__ void p0_prologue(const P0Args& a, LAS unsigned char* lds, int gw, int NGW, int wave, int lane) {
    LAS float* scr = (LAS float*)(lds + RING_OFF + wave * 16384);
    unsigned char* ws = a.ws;
    tr_run(a, 0, TRG_N0, gw, NGW, scr, lane);
    { u32x4* z = (u32x4*)(ws + WS_W1IN + (size_t)2624 * D * 2); const int nz = (N_IN1P - 2624) * D * 2 / 16;
      for (int i = gw * 64 + lane; i < nz; i += NGW * 64) z[i] = (u32x4){0u, 0u, 0u, 0u}; }
    for (int it = gw; it < 64 * 32; it += NGW) if ((it & 31) == 0) { const int ci = it >> 5, type = ci >> 5, chunk = ci & 31; float s = 0.f;
        const float* wp = a.w_cmp + ((size_t)type * 2048 + chunk * 64) * 64 + lane; const float* pp = a.pe_cmp + type * 2048 + chunk * 64;
#pragma unroll 16
        for (int kk = 0; kk < 64; ++kk) s += pp[kk] * wp[(size_t)kk * 64];
        ((float*)(ws + WS_CBIAS + 4096))[ci * 64 + lane] = s; }
    for (int row0 = 4 * gw; row0 < MP; row0 += 4 * NGW) {
        f32x4 v[4][4];
#pragma unroll
        for (int rr = 0; rr < 4; ++rr) { const int row = row0 + rr; const int rc = row < MR ? row : MR - 1;
            const f32x4* xr = (const f32x4*)(rc < NP ? a.xp + (size_t)rc * D : a.xs + (size_t)(rc - NP) * D) + lane;
#pragma unroll
            for (int j = 0; j < 4; ++j) v[rr][j] = xr[64 * j]; }
#pragma unroll
        for (int rr = 0; rr < 4; ++rr) { const int row = row0 + rr; const bool real = row < MR;
            unsigned long long* o8 = (unsigned long long*)(ws + WS_XB + (size_t)row * D * 2) + lane; float* ss = (float*)(ws + WS_SS) + (size_t)row * 16;
            float s = 0.f;
#pragma unroll
            for (int j = 0; j < 4; ++j) { if (!real) v[rr][j] = (f32x4){0.f, 0.f, 0.f, 0.f}; s += (v[rr][j][0] * v[rr][j][0] + v[rr][j][1] * v[rr][j][1]) + (v[rr][j][2] * v[rr][j][2] + v[rr][j][3] * v[rr][j][3]); }
            s = wave_sum(s);
#pragma unroll
            for (int j = 0; j < 4; ++j) o8[64 * j] = (unsigned long long)pk2(v[rr][j][0], v[rr][j][1]) | ((unsigned long long)pk2(v[rr][j][2], v[rr][j][3]) << 32);
            if (lane < 16) ss[lane] = lane == 0 ? s : 0.f; }
    }
}

constexpr int P2_PITCH = 272, P2_VN = 0, P2_WT = 128 * P2_PITCH, P2_MX = 2 * 128 * P2_PITCH;
struct P2Args { const bf16* H0; bf16* YC; const float *conv_w, *norm_v, *w_spatial, *b_spatial, *state_conv, *VSS; float* out; };
__device__ __forceinline__ void p2_unit(const P2Args& a, int u, LAS unsigned char* lds, int tid) {
    asm volatile("" : "+v"(tid));
    const int n = u >> 7, c = (u >> 2) & 31, hd = u & 3;
    const int lane = tid & 63, w = tid >> 6;
    const size_t R0 = (size_t)n * SEQ + c * 128;
    {
        const int cg = tid & 15, ts = tid >> 4, ch = hd * 128 + cg * 8;
        float w0[8], w1[8], w2[8];
#pragma unroll
        for (int k = 0; k < 8; ++k) { w0[k] = a.conv_w[ch + k]; w1[k] = a.conv_w[512 + ch + k]; w2[k] = a.conv_w[1024 + ch + k]; }
#pragma unroll 2
        for (int j = 0; j < 4; ++j) { const int tok = ts + 32 * j, p = c * 128 + tok; const size_t row = R0 + tok; const bf16* hr = a.H0 + row * N_IN0;
            const u32x4 bg = *(const u32x4*)(hr + ch), c0 = *(const u32x4*)(hr + 512 + ch), h0 = *(const u32x4*)(hr + 1024 + ch);
            u32x4 c1 = (u32x4){0u, 0u, 0u, 0u}, h1 = c1, c2 = c1, h2 = c1;
            if (p >= 1) { c1 = *(const u32x4*)(hr - N_IN0 + 512 + ch); h1 = *(const u32x4*)(hr - N_IN0 + 1024 + ch); }
            if (p >= 2) { c2 = *(const u32x4*)(hr - 2 * N_IN0 + 512 + ch); h2 = *(const u32x4*)(hr - 2 * N_IN0 + 1024 + ch); }
            float z0[8], y[8];
#pragma unroll
            for (int k = 0; k < 4; ++k) {
                const float zz0a = bflo(c0[k]) * bflo(h0[k]), zz0b = bfhi(c0[k]) * bfhi(h0[k]);
                const float zz1a = bflo(c1[k]) * bflo(h1[k]), zz1b = bfhi(c1[k]) * bfhi(h1[k]);
                const float zz2a = bflo(c2[k]) * bflo(h2[k]), zz2b = bfhi(c2[k]) * bfhi(h2[k]);
                z0[2 * k] = zz0a; z0[2 * k + 1] = zz0b;
                y[2 * k] = bflo(bg[k]) * (w0[2 * k] * zz2a + w1[2 * k] * zz1a + w2[2 * k] * zz0a);
                y[2 * k + 1] = bfhi(bg[k]) * (w0[2 * k + 1] * zz2b + w1[2 * k + 1] * zz1b + w2[2 * k + 1] * zz0b);
            }
            u32x4 o; o.x = pk2(y[0], y[1]); o.y = pk2(y[2], y[3]); o.z = pk2(y[4], y[5]); o.w = pk2(y[6], y[7]);
            *(u32x4*)(a.YC + row * D + ch) = o;
            if (p >= SEQ - 2) { float* cs = a.out + OFF_CSP + ((size_t)n * 2 + (p - (SEQ - 2))) * 512 + ch;
                *(f32x4*)cs = (f32x4){z0[0], z0[1], z0[2], z0[3]}; *(f32x4*)(cs + 4) = (f32x4){z0[4], z0[5], z0[6], z0[7]}; }
        }
    }
    { const int s = tid >> 2, dq = tid & 3;
      const f32x4 q0 = *(const f32x4*)(a.VSS + (R0 + s) * 8), q1 = *(const f32x4*)(a.VSS + (R0 + s) * 8 + 4);
      const float r = 1.0f / sqrtf((((q0[0] + q0[1]) + (q0[2] + q0[3])) + ((q1[0] + q1[1]) + (q1[2] + q1[3]))) * (1.0f / 512.0f) + RMS_EPS);
#pragma unroll
      for (int i = 0; i < 4; ++i) { const int d = dq * 32 + i * 8; const u32x4 v = *(const u32x4*)(a.H0 + (R0 + s) * N_IN0 + 2048 + hd * 128 + d);
          const f32x4 n0 = *(const f32x4*)(a.norm_v + hd * 128 + d), n1 = *(const f32x4*)(a.norm_v + hd * 128 + d + 4);
          u32x4 o; o.x = pk2(gelu_t(bflo(v[0])) * r * n0[0], gelu_t(bfhi(v[0])) * r * n0[1]); o.y = pk2(gelu_t(bflo(v[1])) * r * n0[2], gelu_t(bfhi(v[1])) * r * n0[3]);
          o.z = pk2(gelu_t(bflo(v[2])) * r * n1[0], gelu_t(bfhi(v[2])) * r * n1[1]); o.w = pk2(gelu_t(bflo(v[3])) * r * n1[2], gelu_t(bfhi(v[3])) * r * n1[3]);
          *(LAS u32x4*)(lds + P2_VN + s * P2_PITCH + d * 2) = o; }
      const int t = s;
#pragma unroll
      for (int i = 0; i < 4; ++i) { const int s0 = dq * 32 + i * 8; const float* wp = a.w_spatial + ((size_t)hd * 128 + t) * 128 + s0;
          const f32x4 x0 = *(const f32x4*)wp, x1 = *(const f32x4*)(wp + 4);
          float x[8] = {x0[0], x0[1], x0[2], x0[3], x1[0], x1[1], x1[2], x1[3]};
#pragma unroll
          for (int k = 0; k < 8; ++k) if (s0 + k > t) x[k] = 0.f;
          u32x4 o; o.x = pk2(x[0], x[1]); o.y = pk2(x[2], x[3]); o.z = pk2(x[4], x[5]); o.w = pk2(x[6], x[7]);
          *(LAS u32x4*)(lds + P2_WT + t * P2_PITCH + s0 * 2) = o; }
    }
    __syncthreads();
    {
        const int tt = w & 3, dh = w >> 2, i = lane & 31, hh = lane >> 5;
        f32x16 acc0, acc1;
#pragma unroll
        for (int r = 0; r < 16; ++r) { acc0[r] = 0.f; acc1[r] = 0.f; }
        const int nks = 2 * (tt + 1);
        const LAS unsigned char* ap = lds + P2_WT + (32 * tt + i) * P2_PITCH + 16 * hh;
        const LAS unsigned char* vp = lds + P2_VN + (8 * hh + ((lane & 15) >> 2)) * P2_PITCH + (64 * dh + 16 * ((lane >> 4) & 1)) * 2 + 8 * (lane & 3);
        for (int ks = 0; ks < nks; ++ks) {
            const bf16x8 af = *(const LAS bf16x8*)(ap + ks * 32);
            const LAS unsigned char* v0 = vp + ks * 16 * P2_PITCH;
            const bf16x8 b0 = cat8(tr16(v0), tr16(v0 + 4 * P2_PITCH));
            const bf16x8 b1 = cat8(tr16(v0 + 64), tr16(v0 + 64 + 4 * P2_PITCH));
            acc0 = MFMA32(af, b0, acc0); acc1 = MFMA32(af, b1, acc1);
        }
#pragma unroll
        for (int r = 0; r < 16; ++r) { LAS bf16* mp = (LAS bf16*)(lds + P2_MX + (32 * tt + crow(r, hh)) * P2_PITCH) + 64 * dh + i;
            mp[0] = (bf16)(pk2(acc0[r], 0.f) & 0xffffu); mp[32] = (bf16)(pk2(acc1[r], 0.f) & 0xffffu); }
    }
    __syncthreads();
    { const int t = tid >> 2, dq = tid & 3; const size_t row = R0 + t; const float bs = a.b_spatial[hd * 128 + t];
#pragma unroll
      for (int i = 0; i < 4; ++i) { const int d = dq * 32 + i * 8;
          const u32x4 uu = *(const u32x4*)(a.H0 + row * N_IN0 + 1536 + hd * 128 + d); const u32x4 mx = *(const LAS u32x4*)(lds + P2_MX + t * P2_PITCH + d * 2);
          u32x4 o;
#pragma unroll
          for (int k = 0; k < 4; ++k) o[k] = pk2(gelu_t(bflo(uu[k])) * (bflo(mx[k]) + bs), gelu_t(bfhi(uu[k])) * (bfhi(mx[k]) + bs));
          *(u32x4*)(a.YC + row * D + 512 + hd * 128 + d) = o; } }
    __syncthreads();
}
__device__ __forceinline__ void p2_sample_row(const P2Args& a, int b, int lane) {
    const size_t row = (size_t)NP + b; const int ch = lane * 8; const bf16* hr = a.H0 + row * N_IN0;
    const u32x4 bg = *(const u32x4*)(hr + ch), cg = *(const u32x4*)(hr + 512 + ch), hc = *(const u32x4*)(hr + 1024 + ch), uu = *(const u32x4*)(hr + 1536 + ch), vv = *(const u32x4*)(hr + 2048 + ch);
    float bgf[8], z0[8], uf[8], gv[8];
#pragma unroll
    for (int k = 0; k < 4; ++k) { bgf[2 * k] = bflo(bg[k]); bgf[2 * k + 1] = bfhi(bg[k]); z0[2 * k] = bflo(cg[k]) * bflo(hc[k]); z0[2 * k + 1] = bfhi(cg[k]) * bfhi(hc[k]);
        uf[2 * k] = bflo(uu[k]); uf[2 * k + 1] = bfhi(uu[k]); gv[2 * k] = gelu_t(bflo(vv[k])); gv[2 * k + 1] = gelu_t(bfhi(vv[k])); }
    float s = 0.f;
#pragma unroll
    for (int k = 0; k < 8; ++k) s += gv[k] * gv[k];
    s = wave_sum(s); const float r = 1.0f / sqrtf(s * (1.0f / 512.0f) + RMS_EPS);
    const float* h0p = a.state_conv + ((size_t)b * 2 + 0) * 512 + ch; const float* h1p = a.state_conv + ((size_t)b * 2 + 1) * 512 + ch;
    const int hd = ch >> 7; const float w00 = a.w_spatial[(size_t)hd * 128 * 128], b0 = a.b_spatial[hd * 128];
    float yc[8], ym[8], vn[8], h1v[8];
#pragma unroll
    for (int k = 0; k < 8; ++k) { const float hist0 = h0p[k], hist1 = h1p[k]; h1v[k] = hist1;
        yc[k] = bgf[k] * (a.conv_w[ch + k] * hist0 + a.conv_w[512 + ch + k] * hist1 + a.conv_w[1024 + ch + k] * z0[k]);
        vn[k] = gv[k] * r * a.norm_v[ch + k]; ym[k] = gelu_t(uf[k]) * (w00 * vn[k] + b0); }
    u32x4 o; o.x = pk2(yc[0], yc[1]); o.y = pk2(yc[2], yc[3]); o.z = pk2(yc[4], yc[5]); o.w = pk2(yc[6], yc[7]);
    *(u32x4*)(a.YC + row * D + ch) = o;
    o.x = pk2(ym[0], ym[1]); o.y = pk2(ym[2], ym[3]); o.z = pk2(ym[4], ym[5]); o.w = pk2(ym[6], ym[7]);
    *(u32x4*)(a.YC + row * D + 512 + ch) = o;
    float* cs = a.out + OFF_CSS + (size_t)b * 1024 + ch;
    *(f32x4*)cs = (f32x4){h1v[0], h1v[1], h1v[2], h1v[3]}; *(f32x4*)(cs + 4) = (f32x4){h1v[4], h1v[5], h1v[6], h1v[7]};
    *(f32x4*)(cs + 512) = (f32x4){z0[0], z0[1], z0[2], z0[3]}; *(f32x4*)(cs + 516) = (f32x4){z0[4], z0[5], z0[6], z0[7]};
    float* cv = a.out + OFF_CVS + (size_t)b * 512 + ch;
    *(f32x4*)cv = (f32x4){vn[0], vn[1], vn[2], vn[3]}; *(f32x4*)(cv + 4) = (f32x4){vn[4], vn[5], vn[6], vn[7]};
}

__device__ __forceinline__ u32x2 pk4(f32x4 v, float s) { u32x2 o; o.x = pk2(v[0] * s, v[1] * s); o.y = pk2(v[2] * s, v[3] * s); return o; }

constexpr int CP_PITCH = 272, CP_TYPE = 32 * CP_PITCH, CP_BUF = 2 * CP_TYPE;
struct CmpArgs { const float* cache_kv; const int* page_table; const bf16* WCMP; float* PQ; unsigned* flags; };
__device__ __forceinline__ void cmp_sample_unit(const CmpArgs& a, int b, int half, LAS unsigned char* lds, int tid) {
    asm volatile("" : "+v"(tid));
    const int lane = tid & 63, w = __builtin_amdgcn_readfirstlane(tid >> 6), type = w >> 2, ntile = w & 3, i = lane & 31, hh = lane >> 5;
    const int row16 = tid >> 5, seg = row16 >> 1, lx = row16 & 1, chunk = tid & 31;
    const int ltype = chunk >> 4, lg = (chunk >> 2) & 3, ld0 = (chunk & 3) * 16;
    int phys[8];
#pragma unroll
    for (int p = 0; p < 8; ++p) phys[p] = __builtin_amdgcn_readfirstlane(a.page_table[b * 16 + half * 8 + p]);
    const float* gsrc0 = a.cache_kv + (size_t)(seg * 16 + lx) * 1024 + chunk * 16;
    LAS unsigned char* sdst = lds + ltype * CP_TYPE + (lg * 8 + seg) * CP_PITCH + (lx * 64 + ld0) * 2;
    const LAS unsigned char* ard = lds + type * CP_TYPE + i * CP_PITCH + 16 * hh;
    const bf16* brd = a.WCMP + (size_t)(type * 128 + ntile * 32 + i) * 1024 + 8 * hh;
    f32x16 acc[4];
    f32x4 rs[4][4];
#define CP_LOAD(SET, E, PH) do { const float* g_ = gsrc0 + ((size_t)(PH) * 128 + 2 * (E)) * 1024; _Pragma("unroll") for (int q_ = 0; q_ < 4; ++q_) rs[SET][q_] = *(const f32x4*)(g_ + 4 * q_); } while (0)
#define CP_STORE(SET, BUF) do { u32x4 o0_, o1_; o0_.x = pk2(rs[SET][0][0], rs[SET][0][1]); o0_.y = pk2(rs[SET][0][2], rs[SET][0][3]); o0_.z = pk2(rs[SET][1][0], rs[SET][1][1]); o0_.w = pk2(rs[SET][1][2], rs[SET][1][3]); \
        o1_.x = pk2(rs[SET][2][0], rs[SET][2][1]); o1_.y = pk2(rs[SET][2][2], rs[SET][2][3]); o1_.z = pk2(rs[SET][3][0], rs[SET][3][1]); o1_.w = pk2(rs[SET][3][2], rs[SET][3][3]); \
        *(LAS u32x4*)(sdst + (BUF) * CP_BUF) = o0_; *(LAS u32x4*)(sdst + (BUF) * CP_BUF + 16) = o1_; } while (0)
    CP_LOAD(0, 0, phys[0]); CP_LOAD(1, 0, phys[1]); CP_LOAD(2, 0, phys[2]); CP_LOAD(3, 0, phys[3]); CP_STORE(0, 0); CP_LOAD(0, 1, phys[0]);
    asm volatile("s_waitcnt lgkmcnt(0)" ::: "memory"); __builtin_amdgcn_s_barrier(); asm volatile("" ::: "memory");
#pragma unroll 1
    for (int ep = 0; ep < 16; ++ep) { const int e = ep & 7, pass = ep >> 3;
        bf16x8 bfr[8];
#pragma unroll
        for (int ks = 0; ks < 8; ++ks) bfr[ks] = *(const bf16x8*)(brd + e * 128 + ks * 16);
        if (e == 0) {
#pragma unroll
            for (int p = 0; p < 4; ++p)
#pragma unroll
                for (int r = 0; r < 16; ++r) acc[p][r] = 0.f; }
#pragma unroll
        for (int p = 0; p < 4; ++p) {
            if (p < 3 || ep < 15) CP_STORE((p + 1) & 3, (p + 1) & 1);
            { const int p5 = (p + 5) & 3, ep5 = ep + ((p + 5) >> 2);
              if (ep5 < 16) { int pa_ = phys[p5], pb_ = phys[4 + p5]; asm volatile("" : "+s"(pa_), "+s"(pb_));
                  const int ph = (ep5 >> 3) ? pb_ : pa_; CP_LOAD((p + 1) & 3, ep5 & 7, ph); } }
            __builtin_amdgcn_sched_barrier(0);
            { bf16x8 af[8];
#pragma unroll
              for (int ks = 0; ks < 8; ++ks) af[ks] = *(const LAS bf16x8*)(ard + (p & 1) * CP_BUF + ks * 32);
#pragma unroll
              for (int ks = 0; ks < 8; ++ks) acc[p] = MFMA32(af[ks], bfr[ks], acc[p]); }
            asm volatile("s_waitcnt lgkmcnt(0)" ::: "memory"); __builtin_amdgcn_s_barrier(); asm volatile("" ::: "memory");
        }
        if (e == 7) {
#pragma unroll
            for (int p = 0; p < 4; ++p)
#pragma unroll
                for (int r = 0; r < 16; ++r) { const int ri = crow(r, hh), g = ri >> 3, sg = ri & 7;
                    a.PQ[((size_t)((type * NSMP + b) * 4 + g) * 128 + (half * 8 + pass * 4 + p) * 8 + sg) * 256 + type * 128 + ntile * 32 + i] = acc[p][r]; } }
    }
#undef CP_LOAD
#undef CP_STORE
    asm volatile("s_waitcnt vmcnt(0) lgkmcnt(0)" ::: "memory"); __syncthreads();
    if (tid == 0) { __builtin_amdgcn_fence(__ATOMIC_RELEASE, "agent"); asm volatile("s_waitcnt vmcnt(0)" ::: "memory");
        (void)__hip_atomic_fetch_add(a.flags + 64 * b, 1u, __ATOMIC_RELAXED, __HIP_MEMORY_SCOPE_AGENT); }
}

__device__ __forceinline__ void cmp_prompt_unit(const bf16* __restrict__ KVB, const bf16* __restrict__ WCMP, float* __restrict__ PQ, int u, LAS unsigned char* lds, int tid) {
    asm volatile("" : "+v"(tid));
    const int lane = tid & 63, w = __builtin_amdgcn_readfirstlane(tid >> 6), i = lane & 31, hh = lane >> 5, ty = u >> 7;
    const bf16* ap = KVB + (size_t)(32 * u + i) * 1024 + 128 * w + 8 * hh;
    const bf16* bp = WCMP + (size_t)(128 * ty + i) * 1024 + 128 * w + 8 * hh;
    f32x16 acc[4];
#pragma unroll
    for (int ct = 0; ct < 4; ++ct)
#pragma unroll
        for (int r = 0; r < 16; ++r) acc[ct][r] = 0.f;
#pragma unroll 1
    for (int s0 = 0; s0 < 8; s0 += 4) { bf16x8 af[4], bf[4][4];
#pragma unroll
        for (int s = 0; s < 4; ++s) { af[s] = *(const bf16x8*)(ap + 16 * (s0 + s));
#pragma unroll
            for (int ct = 0; ct < 4; ++ct) bf[s][ct] = *(const bf16x8*)(bp + (size_t)32 * ct * 1024 + 16 * (s0 + s)); }
        __builtin_amdgcn_sched_barrier(0);
#pragma unroll
        for (int s = 0; s < 4; ++s)
#pragma unroll
            for (int ct = 0; ct < 4; ++ct) acc[ct] = MFMA32(af[s], bf[s][ct], acc[ct]);
        __builtin_amdgcn_sched_barrier(0); }
    LAS float* red = (LAS float*)lds;
#pragma unroll
    for (int ct = 0; ct < 4; ++ct)
#pragma unroll
        for (int r4 = 0; r4 < 4; ++r4) *(LAS f32x4*)(red + ((((w * 4 + ct) * 4 + r4) * 64) + lane) * 4) = (f32x4){acc[ct][4 * r4], acc[ct][4 * r4 + 1], acc[ct][4 * r4 + 2], acc[ct][4 * r4 + 3]};
    __syncthreads();
#pragma unroll
    for (int bb = 0; bb < 2; ++bb) { const int blk = 2 * w + bb, ct = blk >> 2, r4 = blk & 3;
        f32x4 sum = (f32x4){0.f, 0.f, 0.f, 0.f};
#pragma unroll
        for (int ws = 0; ws < 8; ++ws) sum = sum + *(const LAS f32x4*)(red + ((((ws * 4 + ct) * 4 + r4) * 64) + lane) * 4);
        float* op = PQ + ((size_t)CMP_ROWS_S + 32 * u + 8 * r4 + 4 * hh) * 256 + 128 * ty + 32 * ct + i;
#pragma unroll
        for (int j = 0; j < 4; ++j) op[(size_t)j * 256] = sum[j]; }
    __syncthreads();
}

constexpr int AP = 144;
constexpr int A_CK = 0, A_CV = 32768, A_RING = 65536, A_SLOT = 16384, A_NSLOT = 3, A_IMP = A_RING + A_NSLOT * A_SLOT, A_ROWF = A_IMP + 8 * 8 * 64 * 4, A_MSK = A_ROWF + 8 * 32 * 4, A_END = A_MSK + 8 * 8 * 8;
static_assert(A_END <= LDSCTL_OFF, "attention LDS map");
struct AttnArgs { const bf16 *Q, *QR, *KVB; const float *PQ, *CB, *G; bf16* O; };

__device__ __forceinline__ void row_factors(LAS float* rowf, float f, int q, int hh, float (&fr)[16]) {
    if (hh == 0) rowf[q] = f;
#pragma unroll
    for (int r = 0; r < 16; ++r) fr[r] = rowf[crow(r, hh)];
}

template <int MODE>
__device__ __forceinline__ void flash_branch(const bf16* __restrict__ Kg, const bf16* __restrict__ Vg, int tile_lo, int tile_hi, const bf16x8 (&qf)[4], int t, unsigned long long mlane,
                                             f32x16& o0, f32x16& o1, float& l_out, LAS unsigned char* lds, LAS float* rowf, int tid, int lane) {
    asm volatile("" : "+v"(tid), "+v"(lane));
    const int i = lane & 31, hh = lane >> 5; const int w = __builtin_amdgcn_readfirstlane(tid >> 6);
    const bf16* ksrc = Kg + (size_t)lane * 64 + 8 * w;
    const bf16* vsrc = Vg + (size_t)(16 * (w & 3) + (lane >> 2)) * 64 + 32 * (w >> 2) + 8 * (lane & 3);
    LAS unsigned char* ring = lds + A_RING + w * 1024;
#define FB_ISSUE(T, S) do { __builtin_amdgcn_global_load_lds((const unsigned*)(ksrc + (size_t)(T) * 4096), (LAS unsigned*)(ring + (S) * A_SLOT), 16, 0, 0); \
                            __builtin_amdgcn_global_load_lds((const unsigned*)(vsrc + (size_t)(T) * 4096), (LAS unsigned*)(ring + (S) * A_SLOT + 8192), 16, 0, 0); } while (0)
    float l = 0.f; bool seen = false;
    f32x16 negm;
#pragma unroll
    for (int r = 0; r < 16; ++r) { o0[r] = 0.f; o1[r] = 0.f; negm[r] = 0.f; }
    asm volatile("s_waitcnt vmcnt(0)" ::: "memory");
    FB_ISSUE(tile_lo, 0); if (tile_lo < tile_hi) FB_ISSUE(tile_lo + 1, 1);
    int sc = 0, sn = 2;
    const LAS unsigned char* kbase = lds + A_RING + kappa(i) * 16 + hh * 1024;
    const LAS unsigned char* vbase = lds + A_RING + 8192 + hh * 1024 + ((lane & 15) >> 2) * 64 + ((lane >> 4) & 1) * 32 + (lane & 3) * 8;
    for (int tile = tile_lo; tile <= tile_hi; ++tile) {
        if (tile < tile_hi) asm volatile("s_waitcnt vmcnt(2)" ::: "memory"); else asm volatile("s_waitcnt vmcnt(0)" ::: "memory");
        __builtin_amdgcn_s_barrier(); asm volatile("" ::: "memory");
        if (tile + 2 <= tile_hi) FB_ISSUE(tile + 2, sn);
        const LAS unsigned char* kt = kbase + sc * A_SLOT; const LAS unsigned char* vt = vbase + sc * A_SLOT;
        sc = sc == 2 ? 0 : sc + 1; sn = sn == 2 ? 0 : sn + 1;
        const bool sel = MODE == 0 ? ((mlane >> tile) & 1ull) != 0ull : true;
        if (__any(sel)) {
            f32x16 s0, s1;
            if (MODE == 0) {
#pragma unroll
                for (int r = 0; r < 16; ++r) s0[r] = sel ? negm[r] : -1e30f;
            } else s0 = negm;
            s1 = s0;
            { bf16x8 kf[8];
#pragma unroll
              for (int st = 0; st < 4; ++st) { kf[2 * st] = *(const LAS bf16x8*)(kt + st * 2048); kf[2 * st + 1] = *(const LAS bf16x8*)(kt + st * 2048 + 512); }
              __builtin_amdgcn_sched_barrier(0);
#pragma unroll
              for (int st = 0; st < 4; ++st) { s0 = MFMA32(kf[2 * st], qf[st], s0); s1 = MFMA32(kf[2 * st + 1], qf[st], s1); } }
            s16x4 vr0[8];
#pragma unroll
            for (int s2 = 0; s2 < 2; ++s2) { const LAS unsigned char* v0 = vt + 8 * s2 * 64;
                vr0[4 * s2] = tr16(v0); vr0[4 * s2 + 1] = tr16(v0 + 4 * 64); vr0[4 * s2 + 2] = tr16(v0 + 4096); vr0[4 * s2 + 3] = tr16(v0 + 4096 + 4 * 64); }
            __builtin_amdgcn_sched_barrier(0);
            const bool bnd = (tile == tile_hi) || (MODE == 1 && tile + 8 == tile_hi);
            if (bnd) {
                const int kb = 64 * tile + 16 * hh;
#pragma unroll
                for (int r = 0; r < 16; ++r) { const int k0 = kb + r, k1 = kb + 32 + r;
                    const bool v0 = MODE == 0 ? (k0 <= t) : (k0 <= t && k0 + 512 > t), v1 = MODE == 0 ? (k1 <= t) : (k1 <= t && k1 + 512 > t);
                    s0[r] = v0 ? s0[r] : -1e30f; s1[r] = v1 ? s1[r] : -1e30f; }
            }
            const bool exact = __any(sel && !seen);
            if (exact) {
                asm volatile("s_nop 15\n\ts_nop 7" : "+v"(s0), "+v"(s1));
                float tm = max3f(s0[0], s1[0], s0[1]), tm2 = max3f(s1[1], s0[2], s1[2]);
#pragma unroll
                for (int r = 3; r < 15; r += 2) { tm = max3f(tm, s0[r], s1[r]); tm2 = max3f(tm2, s0[r + 1], s1[r + 1]); }
                tm = max3f(tm, s0[15], s1[15]); tm = xhalf_max(fmaxf(tm, tm2));
                const bool first = !seen && tm > -1e29f; const bool resc = first || (seen && tm > 8.0f);
                if (__any(resc)) {
                    const float delta = resc ? tm : 0.f; const float alpha = (resc && !first) ? __builtin_amdgcn_exp2f(-delta) : 1.0f; l *= alpha; seen = seen || first;
#pragma unroll
                    for (int r = 0; r < 16; ++r) { negm[r] -= delta; s0[r] -= delta; s1[r] -= delta; }
                    float fr[16]; row_factors(rowf, alpha, i, hh, fr);
#pragma unroll
                    for (int r = 0; r < 16; ++r) { o0[r] *= fr[r]; o1[r] *= fr[r]; }
                }
            }
            f32x2_t la = {0.f, 0.f}, lb = {0.f, 0.f};
#pragma unroll
            for (int r = 0; r < 16; r += 2) { s0[r] = __builtin_amdgcn_exp2f(s0[r]); s0[r + 1] = __builtin_amdgcn_exp2f(s0[r + 1]); s1[r] = __builtin_amdgcn_exp2f(s1[r]); s1[r + 1] = __builtin_amdgcn_exp2f(s1[r + 1]);
                la += (f32x2_t){s0[r], s0[r + 1]}; lb += (f32x2_t){s1[r], s1[r + 1]}; }
            la += lb; const float ls = la[0] + la[1];
            l += ls;
            { bf16x8 pa[2]; s16x4 vr1[8];
#pragma unroll
              for (int s2 = 0; s2 < 2; ++s2) { u32x4 pw;
#pragma unroll
                  for (int k = 0; k < 4; ++k) pw[k] = pk2(s0[8 * s2 + 2 * k], s0[8 * s2 + 2 * k + 1]);
                  pa[s2] = __builtin_bit_cast(bf16x8, pw); }
#pragma unroll
              for (int s2 = 0; s2 < 2; ++s2) { const LAS unsigned char* v0 = vt + 2 * 1024 + 8 * s2 * 64;
                  vr1[4 * s2] = tr16(v0); vr1[4 * s2 + 1] = tr16(v0 + 4 * 64); vr1[4 * s2 + 2] = tr16(v0 + 4096); vr1[4 * s2 + 3] = tr16(v0 + 4096 + 4 * 64); }
              __builtin_amdgcn_sched_barrier(0);
#pragma unroll
              for (int s2 = 0; s2 < 2; ++s2) { o0 = MFMA32(pa[s2], cat8(vr0[4 * s2], vr0[4 * s2 + 1]), o0); o1 = MFMA32(pa[s2], cat8(vr0[4 * s2 + 2], vr0[4 * s2 + 3]), o1); }
#pragma unroll
              for (int s2 = 0; s2 < 2; ++s2) { u32x4 pw;
#pragma unroll
                  for (int k = 0; k < 4; ++k) pw[k] = pk2(s1[8 * s2 + 2 * k], s1[8 * s2 + 2 * k + 1]);
                  pa[s2] = __builtin_bit_cast(bf16x8, pw); }
              __builtin_amdgcn_sched_barrier(0);
#pragma unroll
              for (int s2 = 0; s2 < 2; ++s2) { o0 = MFMA32(pa[s2], cat8(vr1[4 * s2], vr1[4 * s2 + 1]), o0); o1 = MFMA32(pa[s2], cat8(vr1[4 * s2 + 2], vr1[4 * s2 + 3]), o1); } }
            if (!exact && __any(ls > 4096.0f)) {
                const float lm = xhalf_max(ls); const bool big = lm > 4096.0f;
                const int e = big ? __builtin_amdgcn_frexp_expf(lm) : 0; const float alpha = __builtin_amdgcn_ldexpf(1.0f, -e), delta = (float)e;
                l *= alpha;
#pragma unroll
                for (int r = 0; r < 16; ++r) negm[r] -= delta;
                float fr[16]; row_factors(rowf, alpha, i, hh, fr);
#pragma unroll
                for (int r = 0; r < 16; ++r) { o0[r] *= fr[r]; o1[r] *= fr[r]; }
            }
        }
        asm volatile("s_waitcnt lgkmcnt(0)" ::: "memory");
    }
    __builtin_amdgcn_s_barrier(); asm volatile("" ::: "memory");
#undef FB_ISSUE
    l_out = xhalf_sum(l);
}

__device__ __forceinline__ void attn_build_ckcv(const AttnArgs& a, int ng, LAS unsigned char* lds, int tid) {
    asm volatile("" : "+v"(tid));
    const int c = tid >> 1, e0 = (tid & 1) * 32; const int cc = c < 255 ? c : 254; const float keep = c < 255 ? 1.0f : 0.0f;
    const float* pk = a.PQ + ((size_t)CMP_ROWS_S + (size_t)ng * 256 + cc) * 256 + e0; const float* pv = a.PQ + ((size_t)CMP_ROWS_S + (size_t)(16 + ng) * 256 + cc) * 256 + e0;
    const float* cb = a.CB + e0;
    LAS unsigned char* dk = lds + A_CK + (e0 >> 3) * 4096 + c * 16; LAS unsigned char* dv = lds + A_CV + ((e0 >> 5) * 16 + (c >> 4)) * 1024 + (c & 15) * 64;
#pragma unroll 2
    for (int k = 0; k < 8; ++k) { const int e = 4 * k;
        const f32x4 kv = (*(const f32x4*)(pk + e) + *(const f32x4*)(pk + 256 + 64 + e) + *(const f32x4*)(cb + e)) * keep;
        const f32x4 vv = (*(const f32x4*)(pv + 128 + e) + *(const f32x4*)(pv + 256 + 192 + e) + *(const f32x4*)(cb + 64 + e)) * keep;
        *(LAS u32x2*)(dk + (e >> 3) * 4096 + (e & 7) * 2) = pk4(kv, 1.0f); *(LAS u32x2*)(dv + e * 2) = pk4(vv, 1.0f); }
    __syncthreads();
}

__device__ __forceinline__ void attn_prompt_unit(const AttnArgs& a, int n, int g, int qt, LAS unsigned char* lds, int tid) {
    asm volatile("" : "+v"(tid));
    const int lane = tid & 63, w = tid >> 6, i = lane & 31, hh = lane >> 5, tau = i >> 2, h = i & 3;
    const int tb = 64 * qt + 8 * w, t = tb + tau; const size_t row = (size_t)n * SEQ + t; const int ng = n * 4 + g;
    LAS float* rowf = (LAS float*)(lds + A_ROWF) + w * 32;
    LAS float* impb = (LAS float*)(lds + A_IMP) + w * 512;
    bf16x8 qf[4];
#pragma unroll
    for (int st = 0; st < 4; ++st) qf[st] = *(const bf16x8*)(a.Q + row * D + (4 * g + h) * 64 + 16 * st + 8 * hh);
    const float g0 = a.G[row * 48 + g * 12 + h * 3 + 0], g1 = a.G[row * 48 + g * 12 + h * 3 + 1], g2 = a.G[row * 48 + g * 12 + h * 3 + 2];
    __syncthreads();
    f32x16 oa0, oa1;
    unsigned long long mlane = 0ull;
    {
        const LAS unsigned char* kp = lds + A_CK + hh * 4096 + kappa(i) * 16;
        const int cmax = t >= 31 ? ((t - 31) >> 4) : -1;
        float mref = 0.f, sum = 0.f, prevo = 0.f; bool seen = false; float wsum[8][4];
        f32x16 oc0, oc1;
#pragma unroll
        for (int r = 0; r < 16; ++r) { oc0[r] = 0.f; oc1[r] = 0.f; }
        const LAS unsigned char* vp = lds + A_CV + hh * 1024 + ((lane & 15) >> 2) * 64 + 32 * ((lane >> 4) & 1) + 8 * (lane & 3);
#pragma unroll
        for (int T = 0; T < 8; ++T) { f32x16 acc;
#pragma unroll
            for (int r = 0; r < 16; ++r) acc[r] = -mref;
            { bf16x8 kf[4];
#pragma unroll
              for (int st = 0; st < 4; ++st) kf[st] = *(const LAS bf16x8*)(kp + T * 512 + st * 8192);
              __builtin_amdgcn_sched_barrier(0);
#pragma unroll
              for (int st = 0; st < 4; ++st) acc = MFMA32(kf[st], qf[st], acc); }
            const int kb = 32 * T + 16 * hh; float tm = -1e30f;
#pragma unroll
            for (int r = 0; r < 16; ++r) { acc[r] = (kb + r) <= cmax ? acc[r] : -1e30f; tm = fmaxf(tm, acc[r]); }
            tm = xhalf_max(tm);
            const bool first = !seen && tm > -1e29f; const bool resc = first || (seen && tm > 8.0f);
            if (__any(resc)) {
                const float delta = resc ? tm : 0.f; const float alpha = (resc && !first) ? __builtin_amdgcn_exp2f(-delta) : 1.0f; mref += delta; sum *= alpha; prevo *= alpha; seen = seen || first;
#pragma unroll
                for (int r = 0; r < 16; ++r) acc[r] -= delta;
#pragma unroll
                for (int T2 = 0; T2 < 8; ++T2) if (T2 < T) {
#pragma unroll
                    for (int jl = 0; jl < 4; ++jl) wsum[T2][jl] *= alpha; }
                float fr[16]; row_factors(rowf, alpha, i, hh, fr);
#pragma unroll
                for (int r = 0; r < 16; ++r) { oc0[r] *= fr[r]; oc1[r] *= fr[r]; }
            }
#pragma unroll
            for (int r = 0; r < 16; ++r) { acc[r] = __builtin_amdgcn_exp2f(acc[r]); sum += acc[r]; }
            const float o15 = xhalf_other(acc[15], hh); const float left = hh ? o15 : prevo; prevo = o15;
#pragma unroll
            for (int jl = 0; jl < 4; ++jl) wsum[T][jl] = (acc[4 * jl] + acc[4 * jl + 1]) + (acc[4 * jl + 2] + acc[4 * jl + 3]) + (jl == 0 ? left : acc[jl == 0 ? 0 : 4 * jl - 1]);
#pragma unroll
            for (int s2 = 0; s2 < 2; ++s2) { u32x4 pw;
#pragma unroll
                for (int k = 0; k < 4; ++k) pw[k] = pk2(acc[8 * s2 + 2 * k], acc[8 * s2 + 2 * k + 1]);
                const bf16x8 pa = __builtin_bit_cast(bf16x8, pw);
                const LAS unsigned char* v0 = vp + T * 2048 + s2 * 512;
                oc0 = MFMA32(pa, cat8(tr16(v0), tr16(v0 + 256)), oc0);
                oc1 = MFMA32(pa, cat8(tr16(v0 + 16384), tr16(v0 + 16384 + 256)), oc1); }
            __builtin_amdgcn_sched_barrier(0);
        }
        sum = xhalf_sum(sum);
        const float inv = sum > 0.f ? 1.0f / sum : 0.f;
#pragma unroll
        for (int T = 0; T < 8; ++T)
#pragma unroll
            for (int jl = 0; jl < 4; ++jl) { float ws = wsum[T][jl] * inv; ws += lane_xor<1>(ws); ws += lane_xor<2>(ws);
                if (h == 0) impb[tau * 64 + 8 * T + 4 * hh + jl] = ws; }
        float fr[16]; row_factors(rowf, g0 * inv, i, hh, fr);
#pragma unroll
        for (int r = 0; r < 16; ++r) { oa0[r] = oc0[r] * fr[r]; oa1[r] = oc1[r] * fr[r]; }
    }
    {
        LAS unsigned long long* maskb = (LAS unsigned long long*)(lds + A_MSK) + w * 8;
        const int tk8 = lane >> 3, sub = lane & 7; const int tt = tb + tk8, cur = tt >> 6;
        const f32x4 i0 = *(const LAS f32x4*)(impb + tk8 * 64 + 8 * sub), i1 = *(const LAS f32x4*)(impb + tk8 * 64 + 8 * sub + 4);
        unsigned key[8];
#pragma unroll
        for (int e = 0; e < 8; ++e) { const int j = 8 * sub + e; const float imp = e < 4 ? i0[e & 3] : i1[e & 3];
            const bool valid = j <= cur, forced = (j == 0) || (j == cur) || (j == cur - 1);
            key[e] = valid ? __float_as_uint(imp + (forced ? 1e4f : 0.f)) : 0u; }
        unsigned thr = 0u;
#pragma unroll 1
        for (int bit = 30; bit >= 0; --bit) { const unsigned cand = thr | (1u << bit); int c = 0;
#pragma unroll
            for (int e = 0; e < 8; ++e) c += key[e] >= cand ? 1 : 0;
            float cf = (float)c; cf += dpp_mov<0xB1>(cf); cf += dpp_mov<0x4E>(cf); cf += dpp_mov<0x141>(cf);
            thr = cf >= 16.0f ? cand : thr; }
        unsigned bits = 0u; int c = 0;
#pragma unroll
        for (int e = 0; e < 8; ++e) { const bool s_ = key[e] >= thr; bits |= s_ ? (1u << e) : 0u; c += s_ ? 1 : 0; }
        float cf = (float)c; cf += dpp_mov<0xB1>(cf); cf += dpp_mov<0x4E>(cf); cf += dpp_mov<0x141>(cf);
        if (cur < 16) { bits = 0u;
#pragma unroll
            for (int e = 0; e < 8; ++e) bits |= (8 * sub + e) <= cur ? (1u << e) : 0u; }
        ((LAS unsigned char*)maskb)[tk8 * 8 + sub] = (unsigned char)bits;
        const bool ok = cur < 16 || cf == 16.0f;
        if (!__all(ok)) {
#pragma unroll 1
            for (int tk = 0; tk < 8; ++tk) {
                const int tt2 = tb + tk, cur2 = tt2 >> 6;
                unsigned long long sel;
                if (cur2 < 16) sel = (2ull << cur2) - 1ull;
                else {
                    const float imp = impb[tk * 64 + lane];
                    const bool valid = lane <= cur2, forced = (lane == 0) || (lane == cur2) || (lane == cur2 - 1);
                    const unsigned key1 = valid ? __float_as_uint(imp + (forced ? 1e4f : 0.f)) : 0u;
                    unsigned thr1 = 0u;
#pragma unroll 1
                    for (int bit = 30; bit >= 0; --bit) { const unsigned cand = thr1 | (1u << bit); if (__popcll(__ballot(key1 >= cand)) >= 16) thr1 = cand; }
                    const unsigned long long gt = __ballot(key1 > thr1); unsigned long long eq = __ballot(key1 == thr1);
                    int need = 16 - __popcll(gt); sel = gt;
                    while (need > 0 && eq) { const unsigned long long low = eq & (0ull - eq); sel |= low; eq ^= low; --need; }
                }
                if (lane == 0) maskb[tk] = sel;
            }
        }
        mlane = maskb[tau];
    }
    { int tq = t, hq = h, hhq = hh; asm volatile("" : "+v"(tq), "+v"(hq), "+v"(hhq));
      const bf16* qp = a.QR + ((size_t)n * SEQ + tq) * D + (4 * g + hq) * 64 + 8 * hhq;
#pragma unroll
      for (int st = 0; st < 4; ++st) qf[st] = *(const bf16x8*)(qp + 16 * st); }
    {
        f32x16 o0, o1; float l;
        flash_branch<0>(a.KVB + 2 * KVB_TY + (size_t)ng * SEQ * 64, a.KVB + 3 * KVB_TY + (size_t)ng * SEQ * 64, 0, qt, qf, t, mlane, o0, o1, l, lds, rowf, tid, lane);
        float fr[16]; row_factors(rowf, l > 0.f ? g1 / l : 0.f, i, hh, fr);
#pragma unroll
        for (int r = 0; r < 16; ++r) { oa0[r] += o0[r] * fr[r]; oa1[r] += o1[r] * fr[r]; }
    }
    {
        f32x16 o0, o1; float l;
        flash_branch<1>(a.KVB + 4 * KVB_TY + (size_t)ng * SEQ * 64, a.KVB + 5 * KVB_TY + (size_t)ng * SEQ * 64, qt >= 8 ? qt - 8 : 0, qt, qf, t, 0ull, o0, o1, l, lds, rowf, tid, lane);
        float fr[16]; row_factors(rowf, l > 0.f ? g2 / l : 0.f, i, hh, fr);
#pragma unroll
        for (int r = 0; r < 16; ++r) { oa0[r] += o0[r] * fr[r]; oa1[r] += o1[r] * fr[r]; }
    }
    { int io = i, ho = hh; asm volatile("" : "+v"(io), "+v"(ho));
      bf16* ob = a.O + ((size_t)n * SEQ + tb) * D + 4 * g * 64 + io;
#pragma unroll
      for (int r = 0; r < 16; ++r) { const int q4 = (r & 3) + 8 * (r >> 2);
          bf16* op = ob + (size_t)((q4 >> 2) + ho) * D + (q4 & 3) * 64;
          op[0] = (bf16)(pk2(oa0[r], 0.f) & 0xffffu); op[32] = (bf16)(pk2(oa1[r], 0.f) & 0xffffu); } }
    __syncthreads();
}

constexpr int S_BASE = 133632;
constexpr int S_SC = S_BASE, S_QN = S_BASE + 2048, S_QR = S_BASE + 3072, S_IMP = S_BASE + 4096, S_MASK = S_BASE + 4352, S_PM = S_BASE + 4608, S_PL = S_BASE + 4736, S_PO = S_BASE + 4864, S_END = S_PO + 8 * 4 * 64 * 4;
static_assert(S_BASE >= MISC_OFF + 128 && S_END <= LDS_BYTES, "sample LDS map");
struct SmpArgs { const bf16 *Q, *QR; const float *PQ, *CB, *G, *cache_kv, *cache_win; const int* page_table; const float* out; bf16* O; unsigned* flags; };
__device__ __forceinline__ int nth_bit(unsigned long long m, int n) { for (int x = 0; x < n; ++x) m &= m - 1ull; return __builtin_ctzll(m); }
__device__ __forceinline__ float dot4(f32x4 a, f32x4 b) { return (a[0] * b[0] + a[1] * b[1]) + (a[2] * b[2] + a[3] * b[3]); }
__device__ __forceinline__ float grp16_sum(float v) { return sum16(v); }
__device__ __forceinline__ void smp_update(const f32x4 kx, const f32x4 vx, const bool valid, const f32x4 (&qv)[4], float (&m)[4], float (&l)[4], f32x4 (&o)[4]) {
#pragma unroll
    for (int h = 0; h < 4; ++h) { const float s = grp16_sum(dot4(kx, qv[h]));
        const float mn = valid ? fmaxf(m[h], s) : m[h]; const float al = __builtin_amdgcn_exp2f(m[h] - mn); const float p = valid ? __builtin_amdgcn_exp2f(s - mn) : 0.f;
        l[h] = l[h] * al + p; o[h] = o[h] * al + vx * p; m[h] = mn; }
}
__device__ __forceinline__ void smp_batch(const f32x4 (&kx)[8], const f32x4 (&vx)[8], const f32x4 (&qv)[4], float (&m)[4], float (&l)[4], f32x4 (&o)[4]) {
#pragma unroll
    for (int h = 0; h < 4; ++h) { float s[8];
#pragma unroll
        for (int u = 0; u < 8; ++u) s[u] = grp16_sum(dot4(kx[u], qv[h]));
        const float bm = fmaxf(max3f(max3f(s[0], s[1], s[2]), max3f(s[3], s[4], s[5]), s[6]), s[7]);
        const bool mv = bm > m[h] + 8.0f;
        if (__any(mv)) { const float mn = mv ? bm : m[h]; const float al = __builtin_amdgcn_exp2f(m[h] - mn); l[h] *= al; o[h] = o[h] * al; m[h] = mn; }
#pragma unroll
        for (int u = 0; u < 8; ++u) { const float p = __builtin_amdgcn_exp2f(s[u] - m[h]); l[h] += p; o[h] = o[h] + vx[u] * p; } }
}
__device__ __forceinline__ float smp_merge(float (&m)[4], float (&l)[4], f32x4 (&o)[4], LAS unsigned char* lds, int tid) {
    const int lane = tid & 63, w = tid >> 6, kq = lane >> 4, d4 = lane & 15, hh = lane >> 5;
    LAS float* pm = (LAS float*)(lds + S_PM); LAS float* pl = (LAS float*)(lds + S_PL); LAS float* po = (LAS float*)(lds + S_PO);
#pragma unroll
    for (int h = 0; h < 4; ++h) {
        { const float m2 = lane_xor<16>(m[h]), l2 = lane_xor<16>(l[h]); f32x4 o2; o2[0] = lane_xor<16>(o[h][0]); o2[1] = lane_xor<16>(o[h][1]); o2[2] = lane_xor<16>(o[h][2]); o2[3] = lane_xor<16>(o[h][3]);
          const float mt = fmaxf(m[h], m2), a1 = __builtin_amdgcn_exp2f(m[h] - mt), a2 = __builtin_amdgcn_exp2f(m2 - mt); l[h] = l[h] * a1 + l2 * a2; o[h] = o[h] * a1 + o2 * a2; m[h] = mt; }
        { const float m2 = xhalf_other(m[h], hh), l2 = xhalf_other(l[h], hh); f32x4 o2; o2[0] = xhalf_other(o[h][0], hh); o2[1] = xhalf_other(o[h][1], hh); o2[2] = xhalf_other(o[h][2], hh); o2[3] = xhalf_other(o[h][3], hh);
          const float mt = fmaxf(m[h], m2), a1 = __builtin_amdgcn_exp2f(m[h] - mt), a2 = __builtin_amdgcn_exp2f(m2 - mt); l[h] = l[h] * a1 + l2 * a2; o[h] = o[h] * a1 + o2 * a2; m[h] = mt; }
        if (kq == 0) { *(LAS f32x4*)(po + (w * 4 + h) * 64 + 4 * d4) = o[h]; if (d4 == 0) { pm[w * 4 + h] = m[h]; pl[w * 4 + h] = l[h]; } }
    }
    __syncthreads();
    float res = 0.f;
    if (tid < 256) { const int h = tid >> 6, e = tid & 63; float mt = -1e30f;
#pragma unroll
        for (int ww = 0; ww < 8; ++ww) mt = fmaxf(mt, pm[ww * 4 + h]);
        float L = 0.f, O = 0.f;
#pragma unroll
        for (int ww = 0; ww < 8; ++ww) { const float sc = __builtin_amdgcn_exp2f(pm[ww * 4 + h] - mt); L += pl[ww * 4 + h] * sc; O += po[(ww * 4 + h) * 64 + e] * sc; }
        res = L > 0.f ? O / L : 0.f; }
    __syncthreads();
    return res;
}
__device__ __forceinline__ void attn_sample_item(const SmpArgs& a, int b, int g, LAS unsigned char* lds, int tid) {
    asm volatile("" : "+v"(tid));
    const int lane = tid & 63, w = tid >> 6, kq = lane >> 4, d4 = lane & 15; const size_t row = (size_t)NP + b;
    LAS float* sc = (LAS float*)(lds + S_SC); LAS float* qn = (LAS float*)(lds + S_QN); LAS float* qr = (LAS float*)(lds + S_QR);
    LAS unsigned long long* maskp = (LAS unsigned long long*)(lds + S_MASK);
    if (tid < 64) { unsigned sp = 0u;
        while ((unsigned)__builtin_amdgcn_readfirstlane((int)__hip_atomic_load(a.flags + 64 * b, __ATOMIC_RELAXED, __HIP_MEMORY_SCOPE_AGENT)) < 2u) { __builtin_amdgcn_s_sleep(2); if (++sp > (1u << 20)) break; }
        __builtin_amdgcn_fence(__ATOMIC_ACQUIRE, "agent"); asm volatile("s_waitcnt vmcnt(0)" ::: "memory"); }
    if (tid < 256) { const int hd = tid >> 6, d = tid & 63; qn[tid] = bf1(a.Q[row * D + (4 * g + hd) * 64 + d]); qr[tid] = bf1(a.QR[row * D + (4 * g + hd) * 64 + d]); }
    __syncthreads();
    f32x4 qv[4];
#pragma unroll
    for (int h = 0; h < 4; ++h) qv[h] = *(const LAS f32x4*)(qn + h * 64 + 4 * d4);
    const float* pqk = a.PQ + ((size_t)(b * 4 + g) * 128) * 256 + 4 * d4;
    const float* pqv = a.PQ + ((size_t)((NSMP + b) * 4 + g) * 128) * 256 + 4 * d4;
    { const f32x4 cbk = *(const f32x4*)(a.CB + 4 * d4);
#pragma unroll
      for (int it = 0; it < 4; ++it) { const int c = 16 * w + 4 * it + kq; const int cc = c < 127 ? c : 126;
          const f32x4 kx = *(const f32x4*)(pqk + (size_t)cc * 256) + *(const f32x4*)(pqk + (size_t)(cc + 1) * 256 + 64) + cbk;
#pragma unroll
          for (int h = 0; h < 4; ++h) { const float s = grp16_sum(dot4(kx, qv[h])); if (d4 == 0) sc[h * 128 + c] = c < 127 ? s : -1e30f; } } }
    __syncthreads();
    if (w < 4) { LAS float* r = sc + w * 128; const float v0 = r[lane], v1 = r[lane + 64]; const float mx = wave_max(fmaxf(v0, v1));
        const float p0 = v0 > -1e29f ? __builtin_amdgcn_exp2f(v0 - mx) : 0.f, p1 = v1 > -1e29f ? __builtin_amdgcn_exp2f(v1 - mx) : 0.f;
        const float s = wave_sum(p0 + p1); const float inv = s > 0.f ? 1.0f / s : 0.f; r[lane] = p0 * inv; r[lane + 64] = p1 * inv; }
    __syncthreads();
    if (tid < 64) { float s = 0.f;
        if (tid < 33) for (int nn = 4 * tid - 1; nn <= 4 * tid + 3; ++nn) if (nn >= 0 && nn < 127) s += (sc[nn] + sc[128 + nn]) + (sc[256 + nn] + sc[384 + nn]);
        const bool valid = tid < 33, forced = (tid == 0) || (tid == 32) || (tid == 31);
        const unsigned key = valid ? __float_as_uint(s + (forced ? 1e4f : 0.f)) : 0u;
        unsigned thr = 0u;
#pragma unroll 1
        for (int bit = 30; bit >= 0; --bit) { const unsigned cand = thr | (1u << bit); if (__popcll(__ballot(key >= cand)) >= 16) thr = cand; }
        const unsigned long long gt = __ballot(key > thr); unsigned long long eq = __ballot(key == thr);
        int need = 16 - __popcll(gt); unsigned long long sel = gt;
        while (need > 0 && eq) { const unsigned long long low = eq & (0ull - eq); sel |= low; eq ^= low; --need; }
        if (tid == 0) *maskp = sel; }
    float ocmp;
    { float m[4], l[4]; f32x4 o[4];
#pragma unroll
      for (int h = 0; h < 4; ++h) { m[h] = 0.f; l[h] = 0.f; o[h] = (f32x4){0.f, 0.f, 0.f, 0.f}; }
      const f32x4 cbv = *(const f32x4*)(a.CB + 64 + 4 * d4);
#pragma unroll
      for (int it = 0; it < 4; ++it) { const int c = 16 * w + 4 * it + kq; const int cc = c < 127 ? c : 126;
          const f32x4 vx = *(const f32x4*)(pqv + (size_t)cc * 256 + 128) + *(const f32x4*)(pqv + (size_t)(cc + 1) * 256 + 192) + cbv;
#pragma unroll
          for (int h = 0; h < 4; ++h) { const float p = c < 127 ? sc[h * 128 + cc] : 0.f; o[h] = o[h] + vx * p; l[h] += p; } }
      ocmp = smp_merge(m, l, o, lds, tid);
    }
    const unsigned long long mask = *maskp;
#pragma unroll
    for (int h = 0; h < 4; ++h) qv[h] = *(const LAS f32x4*)(qr + h * 64 + 4 * d4);
    float oslc;
    { float m[4], l[4]; f32x4 o[4];
#pragma unroll
      for (int h = 0; h < 4; ++h) { m[h] = -1e30f; l[h] = 0.f; o[h] = (f32x4){0.f, 0.f, 0.f, 0.f}; }
#pragma unroll 1
      for (int bi = 0; bi < 2; ++bi) { const int j = nth_bit(mask, 2 * w + bi);
          if (j < 32) { const int phys = a.page_table[b * 16 + (j >> 1)];
              const float* base = a.cache_kv + ((size_t)phys * 128 + (j & 1) * 64 + kq) * 1024 + 512 + g * 64 + 4 * d4;
#pragma unroll 1
              for (int it8 = 0; it8 < 2; ++it8) { const float* p0 = base + (size_t)it8 * 32 * 1024; f32x4 kx[8], vx[8];
#pragma unroll
                  for (int u = 0; u < 8; ++u) { kx[u] = *(const f32x4*)(p0 + u * 4096); vx[u] = *(const f32x4*)(p0 + u * 4096 + 256); }
                  smp_batch(kx, vx, qv, m, l, o); } }
          else { const float* p0 = a.out + OFF_KVS + (size_t)b * 1024 + 512 + g * 64 + 4 * d4;
              const f32x4 kx = *(const f32x4*)p0, vx = *(const f32x4*)(p0 + 256); smp_update(kx, vx, kq == 0, qv, m, l, o); } }
      oslc = smp_merge(m, l, o, lds, tid);
    }
    float owin;
    { float m[4], l[4]; f32x4 o[4];
#pragma unroll
      for (int h = 0; h < 4; ++h) { m[h] = -1e30f; l[h] = 0.f; o[h] = (f32x4){0.f, 0.f, 0.f, 0.f}; }
#pragma unroll 1
      for (int it8 = 0; it8 < 2; ++it8) { f32x4 kx[8], vx[8];
#pragma unroll
          for (int u = 0; u < 8; ++u) { const int kk = 64 * w + 32 * it8 + 4 * u + kq;
              const float* p0 = kk < 511 ? a.cache_win + (((size_t)b * 512 + kk + 1) * 2) * 256 + g * 64 + 4 * d4 : a.out + OFF_WINS + (size_t)b * 512 + g * 64 + 4 * d4;
              kx[u] = *(const f32x4*)p0; vx[u] = *(const f32x4*)(p0 + 256); }
          smp_batch(kx, vx, qv, m, l, o); }
      owin = smp_merge(m, l, o, lds, tid);
    }
    if (tid < 256) { const int oh = tid >> 6, oe = tid & 63; const float* gp = a.G + row * 48 + g * 12 + oh * 3;
        const float ov = gp[0] * ocmp + gp[1] * oslc + gp[2] * owin;
        a.O[row * D + (4 * g + oh) * 64 + oe] = (bf16)(pk2(ov, 0.f) & 0xffffu); }
    __syncthreads();
}

constexpr int SK_RED = 0;
template <bool FIRST> __device__ __forceinline__ void skinny_resid(const bf16* __restrict__ A, const bf16* __restrict__ Bt, int K, const float* xs, bf16* XB, float* SS, int u, LAS unsigned char* lds, int tid) {
    typedef float f32x4v __attribute__((ext_vector_type(4)));
    asm volatile("" : "+v"(tid));
    const int lane = tid & 63, w = __builtin_amdgcn_readfirstlane(tid >> 6), r16 = lane & 15, kq = lane >> 4, rt = u & 7, cu = u >> 3;
    const bf16* ap = A + (size_t)(NP + 16 * rt + r16) * K + 8 * kq + 32 * w;
    const bf16* bp = Bt + (size_t)(64 * cu + r16) * K + 8 * kq + 32 * w;
    f32x4v acc[4];
#pragma unroll
    for (int ct = 0; ct < 4; ++ct) acc[ct] = (f32x4v){0.f, 0.f, 0.f, 0.f};
    const int nj = K / 256;
#pragma unroll 1
    for (int j0 = 0; j0 < nj; j0 += 4) { bf16x8 af[4], bf[4][4];
#pragma unroll
        for (int s = 0; s < 4; ++s) { const int j = (j0 + s < nj) ? j0 + s : nj - 1;
            af[s] = *(const bf16x8*)(ap + 256 * j);
#pragma unroll
            for (int ct = 0; ct < 4; ++ct) bf[s][ct] = *(const bf16x8*)(bp + (size_t)16 * ct * K + 256 * j); }
        __builtin_amdgcn_sched_barrier(0);
#pragma unroll
        for (int s = 0; s < 4; ++s) if (j0 + s < nj) {
#pragma unroll
            for (int ct = 0; ct < 4; ++ct) acc[ct] = __builtin_amdgcn_mfma_f32_16x16x32_bf16(af[s], bf[s][ct], acc[ct], 0, 0, 0); }
        __builtin_amdgcn_sched_barrier(0); }
    LAS float* red = (LAS float*)(lds + SK_RED);
#pragma unroll
    for (int ct = 0; ct < 4; ++ct) *(LAS f32x4v*)(red + ((w * 4 + ct) * 64 + lane) * 4) = acc[ct];
    __syncthreads();
#pragma unroll
    for (int rr = 0; rr < 2; ++rr) { const int lr = 2 * w + rr;
        const int ct = lane >> 4, src_lane = (lr >> 2) * 16 + (lane & 15), reg = lr & 3;
        float s = 0.f;
#pragma unroll
        for (int ww = 0; ww < 8; ++ww) s += red[((ww * 4 + ct) * 64 + src_lane) * 4 + reg];
        const int srow = 16 * rt + lr; const size_t row = (size_t)NP + srow; const int col = 64 * cu + lane;
        const float x = (FIRST ? xs[(size_t)srow * D + col] : bf1(XB[row * D + col])) + s;
        XB[row * D + col] = (bf16)(pk2(x, 0.f) & 0xffffu);
        const float sq = wave_sum(x * x);
        if (lane == 0) SS[row * 16 + cu] = sq; }
    __syncthreads();
}


struct Args { const float* in[21]; float* out; unsigned char* ws; };
__global__ void __launch_bounds__(NWAVES * 64, 2) nsa_fwd(Args args) {
    extern __shared__ __attribute__((aligned(16))) unsigned char lds_raw[];
    LAS unsigned char* lds = (LAS unsigned char*)lds_raw;
    volatile LAS unsigned* MISC = (volatile LAS unsigned*)(lds + MISC_OFF);
    const int tid = threadIdx.x;
    const int wave_s = __builtin_amdgcn_readfirstlane(tid >> 6);
    const int G = gridDim.x; const int bx = blockIdx.x; const int vcu = (G % 8 == 0) ? (bx % 8) * (G / 8) + bx / 8 : bx;
    const int NGW = G * NWAVES;
    unsigned char* ws = args.ws; float* out = args.out;
    gu32* ctl = (gu32*)(ws + WS_CTL);
    const float* x_prompt = args.in[0]; const float* x_sample = args.in[1]; const float* state_conv = args.in[2]; const float* cache_kv = args.in[3]; const float* cache_win = args.in[4];
    const int* page_table = (const int*)args.in[5];
    const float* norm_mix = args.in[6]; const float* norm_ffn = args.in[7]; const float* norm_final = args.in[8]; const float* w_in0 = args.in[9]; const float* conv_w = args.in[10];
    const float* norm_v = args.in[11]; const float* w_spatial = args.in[12]; const float* b_spatial = args.in[13]; const float* w_out0 = args.in[14]; const float* w_in1 = args.in[15];
    const float* pe_cmp = args.in[16]; const float* w_cmp = args.in[17]; const float* w_out1 = args.in[18]; const float* w_ffn_in = args.in[19]; const float* w_ffn_out = args.in[20];
    for (int u = tid; u < (LDS_BYTES - LDSCTL_OFF) / 4; u += NWAVES * 64) ((LAS unsigned*)(lds + LDSCTL_OFF))[u] = 0u;
    __syncthreads();
    XcdBarrier bar = xcd_barrier_post((unsigned*)(ctl + CW_BAR), MISC + 8);
#define GRID_BAR() xcd_barrier(bar)
#define WS_PTRS() GAS unsigned char* ws_g = (GAS unsigned char*)ws; asm volatile("" : "+s"(ws_g)); unsigned char* ws_p = (unsigned char*)ws_g;     \
    bf16* W0IN = (bf16*)(ws_p + WS_W0IN); bf16* W0OUT = (bf16*)(ws_p + WS_W0OUT); bf16* WFI0 = (bf16*)(ws_p + WS_WFI0); bf16* WFI1 = (bf16*)(ws_p + WS_WFI1); bf16* WFO0 = (bf16*)(ws_p + WS_WFO0); bf16* WFO1 = (bf16*)(ws_p + WS_WFO1); \
    bf16* W1IN = (bf16*)(ws_p + WS_W1IN); bf16* W1OUT = (bf16*)(ws_p + WS_W1OUT); bf16* WCMP = (bf16*)(ws_p + WS_WCMP); \
    float* SS = (float*)(ws_p + WS_SS); float* CB = (float*)(ws_p + WS_CBIAS); float* GT = (float*)(ws_p + WS_G); float* X = (float*)(ws_p + WS_X); bf16* XB = (bf16*)(ws_p + WS_XB); \
    bf16* H0 = (bf16*)(ws_p + WS_H0); bf16* YC = (bf16*)(ws_p + WS_YC); bf16* ACT = (bf16*)(ws_p + WS_ACT); float* H1 = (float*)(ws_p + WS_H1); bf16* Qb = (bf16*)(ws_p + WS_Q); bf16* QRb = (bf16*)(ws_p + WS_QR); \
    bf16* Ob = (bf16*)(ws_p + WS_O); bf16* CMPA = (bf16*)(ws_p + WS_CMPA); bf16* KVB = (bf16*)(ws_p + WS_KVB); float* PQ = (float*)(ws_p + WS_PQ); \
    (void)W0IN; (void)W0OUT; (void)WFI0; (void)WFI1; (void)WFO0; (void)WFO1; (void)W1IN; (void)W1OUT; (void)WCMP; (void)SS; (void)CB; (void)GT; (void)X; (void)XB; (void)H0; (void)YC; (void)ACT; (void)H1; (void)Qb; (void)QRb; (void)Ob; (void)CMPA; (void)KVB; (void)PQ
#define PHASE_IDS() const int tid_p = fresh_tid(wave_s); const int lane_p = tid_p & 63, wave_p = __builtin_amdgcn_readfirstlane(tid_p >> 6), gw_p = vcu * NWAVES + wave_p; (void)lane_p; (void)gw_p

    { WS_PTRS(); const P0Args pa{x_prompt, x_sample, norm_mix, norm_ffn, w_in0, w_out0, w_in1, pe_cmp, w_cmp, w_out1, w_ffn_in, w_ffn_out, ws};
      PHASE_IDS(); p0_prologue(pa, lds, gw_p, NGW, wave_p, lane_p); }
    GRID_BAR();
    { WS_PTRS();
      { const int nwg = (MP / 256) * (N_IN0 / 256), fi_ = nwg - ((nwg - 1) / G) * G, first_idle = fi_ < G ? fi_ : 0;
        if (bx >= first_idle) { PHASE_IDS(); const P0Args pa{x_prompt, x_sample, norm_mix, norm_ffn, w_in0, w_out0, w_in1, pe_cmp, w_cmp, w_out1, w_ffn_in, w_ffn_out, ws};
            tr_run(pa, 1, TRG_N1, (bx - first_idle) * NWAVES + wave_p, (G - first_idle) * NWAVES, (LAS float*)(lds + RING_OFF + wave_p * 16384), lane_p); __syncthreads(); } }
      pg8::Gemm g{XB, W0IN, MP, N_IN0, D}; pg8::StaticOrder S; S.init(MP, N_IN0, G, bx);
      pg8::EpiScaleBf16 E{H0, N_IN0, SS, (float*)(ws_p + WS_VSS)};
      pg8::gemm_phase<pg8::EpiScaleBf16, pg8::StaticOrder, true, true>(lds + RING_OFF, g, S, E, fresh_tid(wave_s)); }
    GRID_BAR();
    { WS_PTRS(); const P2Args pa{H0, YC, conv_w, norm_v, w_spatial, b_spatial, state_conv, (const float*)(ws_p + WS_VSS), out};
      PHASE_IDS();
      for (int u = vcu; u < 512; u += G) p2_unit(pa, u, lds, tid_p);
      for (int b = gw_p; b < NSMP; b += NGW) p2_sample_row(pa, b, lane_p);
      if (gw_p >= NGW - 2) { const int type = gw_p - (NGW - 2); const float* cp = (const float*)(ws_p + WS_CBIAS + 4096) + (size_t)type * 32 * 64 + lane_p; float s = 0.f;
#pragma unroll
          for (int c = 0; c < 32; ++c) s += cp[c * 64];
          CB[type * 64 + lane_p] = s; } }
    GRID_BAR();
    { WS_PTRS(); pg8::Gemm g{YC, W0OUT, NP, D, D}; pg8::StaticOrder S; S.init(NP, D, G, bx);
      pg8::EpiResid<false> E{nullptr, nullptr, XB, SS};
      pg8::gemm_phase<pg8::EpiResid<false>, pg8::StaticOrder, true, true>(lds + RING_OFF, g, S, E, fresh_tid(wave_s));
      PHASE_IDS(); __syncthreads();
#pragma unroll 1
      for (int u2 = vcu; u2 < 128; u2 += G) skinny_resid<false>(YC, W0OUT, D, nullptr, XB, SS, u2, lds, tid_p); }
    GRID_BAR();
    { WS_PTRS();
      { const int nwg = (MP / 256) * (N_FF2 / 256), fi_ = nwg - ((nwg - 1) / G) * G, first_idle = fi_ < G ? fi_ : 0;
        if (bx >= first_idle) { PHASE_IDS(); const P0Args pa{x_prompt, x_sample, norm_mix, norm_ffn, w_in0, w_out0, w_in1, pe_cmp, w_cmp, w_out1, w_ffn_in, w_ffn_out, ws};
            tr_run(pa, 2, TRG_N2, (bx - first_idle) * NWAVES + wave_p, (G - first_idle) * NWAVES, (LAS float*)(lds + RING_OFF + wave_p * 16384), lane_p); __syncthreads(); } }
      pg8::Gemm g{XB, WFI0, MP, N_FF2, D}; pg8::StaticOrder S; S.init(MP, N_FF2, G, bx);
      pg8::EpiSwiGLU E{ACT, DFF, SS};
      pg8::gemm_phase<pg8::EpiSwiGLU, pg8::StaticOrder, true, true>(lds + RING_OFF, g, S, E, fresh_tid(wave_s)); }
    GRID_BAR();
    { WS_PTRS(); pg8::Gemm g{ACT, WFO0, NP, D, DFF}; pg8::StaticOrder S; S.init(NP, D, G, bx);
      pg8::EpiResid<false> E{nullptr, nullptr, XB, SS};
      pg8::gemm_phase<pg8::EpiResid<false>, pg8::StaticOrder, true, true>(lds + RING_OFF, g, S, E, fresh_tid(wave_s));
      PHASE_IDS(); __syncthreads();
#pragma unroll 1
      for (int u2 = vcu; u2 < 128; u2 += G) skinny_resid<false>(ACT, WFO0, DFF, nullptr, XB, SS, u2, lds, tid_p); }
    GRID_BAR();
    { WS_PTRS();
      { const int nwg = (MP / 256) * (N_IN1P / 256), fi_ = nwg - ((nwg - 1) / G) * G, first_idle = fi_ < G ? fi_ : 0;
        if (bx >= first_idle) { PHASE_IDS(); const P0Args pa{x_prompt, x_sample, norm_mix, norm_ffn, w_in0, w_out0, w_in1, pe_cmp, w_cmp, w_out1, w_ffn_in, w_ffn_out, ws};
            tr_run(pa, 3, TRG_N3, (bx - first_idle) * NWAVES + wave_p, (G - first_idle) * NWAVES, (LAS float*)(lds + RING_OFF + wave_p * 16384), lane_p); __syncthreads(); } }
      pg8::Gemm g{XB, W1IN, MP, N_IN1P, D}; pg8::StaticOrder S; S.init(MP, N_IN1P, G, bx);
      pg8::EpiNsa E{SS, Qb, QRb, KVB, GT, out, OFF_KVP, OFF_KVS, OFF_WINP, OFF_WINS, KVB_TY, C2};
      pg8::gemm_phase<pg8::EpiNsa, pg8::StaticOrder, true, true>(lds + RING_OFF, g, S, E, fresh_tid(wave_s)); }
    GRID_BAR();
    { WS_PTRS(); PHASE_IDS();
#pragma unroll 1
      for (int u = vcu; u < 256; u += G) cmp_prompt_unit(KVB, WCMP, PQ, u, lds, tid_p); }
    GRID_BAR();
    { WS_PTRS(); const AttnArgs pa{Qb, QRb, KVB, PQ, CB, GT, Ob}; PHASE_IDS();
      unsigned* flags = (unsigned*)(ws_p + WS_CTL) + CW_FLAG;
      const SmpArgs sa{Qb, QRb, PQ, CB, GT, cache_kv, cache_win, page_table, out, Ob, flags};
      const CmpArgs ca{cache_kv, page_table, WCMP, PQ, flags};
      { int last_ng = -1; const int ccls = vcu % 3; const bool sown = ((vcu / 3) & 1) == 0;
        unsigned* qctr = (unsigned*)(ws_p + WS_CTL) + CW_QUEUE;
        const int NJ = 3 * ((G / 3) / 2) + (((G / 3) & 1) ? (G % 3) : 0), NT = NJ * ((NSMP * 4 + G - 1) / G);
#pragma unroll 1
      for (int step = 0; step < 6; ++step) {
          if (step == ccls) {
#pragma unroll 1
              for (int u = vcu; u < 2 * NSMP; u += G) cmp_sample_unit(ca, u >> 1, u & 1, lds + A_RING, fresh_tid(wave_s)); }
          if ((step == 3 && sown) || step == 5) { int k = 0;
#pragma unroll 1
              for (;;) { int it;
                  if (step == 3) { it = vcu + k * G; ++k; if (it >= NSMP * 4) break; }
                  else { __syncthreads(); if (threadIdx.x == 0) MISC[24] = __hip_atomic_fetch_add(qctr, 1u, __ATOMIC_RELAXED, __HIP_MEMORY_SCOPE_AGENT); __syncthreads();
                      const int t = (int)MISC[24]; if (t >= NT) break;
                      const int j = t % NJ, v = 6 * (j / 3) + 3 + (j % 3); it = v + G * (t / NJ); if (it >= NSMP * 4) continue; }
                  attn_sample_item(sa, it >> 2, it & 3, lds, fresh_tid(wave_s)); } }
          if (step < 4) {
#pragma unroll 1
              for (int idx = vcu + step * G; idx < 1024; idx += 4 * G) { int ng, qt;
                  if (G == 256) { const int k2 = idx >> 8, v = idx & 255, s = v & 15; ng = v >> 4; qt = k2 == 0 ? s : k2 == 1 ? 31 - s : k2 == 2 ? 32 + s : 63 - s; }
                  else { ng = idx >> 6; qt = idx & 63; }
                  if (ng != last_ng) { attn_build_ckcv(pa, ng, lds, fresh_tid(wave_s)); last_ng = ng; }
                  attn_prompt_unit(pa, ng >> 2, ng & 3, qt, lds, fresh_tid(wave_s)); } } } } }
    GRID_BAR();
    { WS_PTRS(); pg8::Gemm g{Ob, W1OUT, NP, D, D}; pg8::StaticOrder S; S.init(NP, D, G, bx);
      pg8::EpiResid<false> E{nullptr, nullptr, XB, SS};
      pg8::gemm_phase<pg8::EpiResid<false>, pg8::StaticOrder, true, true>(lds + RING_OFF, g, S, E, fresh_tid(wave_s));
      PHASE_IDS(); __syncthreads();
#pragma unroll 1
      for (int u2 = vcu; u2 < 128; u2 += G) skinny_resid<false>(Ob, W1OUT, D, nullptr, XB, SS, u2, lds, tid_p); }
    GRID_BAR();
    { WS_PTRS(); pg8::Gemm g{XB, WFI1, MP, N_FF2, D}; pg8::StaticOrder S; S.init(MP, N_FF2, G, bx);
      pg8::EpiSwiGLU E{ACT, DFF, SS};
      pg8::gemm_phase<pg8::EpiSwiGLU, pg8::StaticOrder, true, true>(lds + RING_OFF, g, S, E, fresh_tid(wave_s)); }
    GRID_BAR();
    { WS_PTRS(); pg8::Gemm g{ACT, WFO1, NP, D, DFF}; pg8::StaticOrder S; S.init(NP, D, G, bx);
      pg8::EpiResid<false> E{nullptr, nullptr, XB, SS};
      pg8::gemm_phase<pg8::EpiResid<false>, pg8::StaticOrder, true, true>(lds + RING_OFF, g, S, E, fresh_tid(wave_s));
      PHASE_IDS(); __syncthreads();
#pragma unroll 1
      for (int u2 = vcu; u2 < 128; u2 += G) skinny_resid<false>(ACT, WFO1, DFF, nullptr, XB, SS, u2, lds, tid_p); }
    GRID_BAR();
    { WS_PTRS(); PHASE_IDS();
    for (int row = gw_p; row < MR; row += NGW) {
        const float rs = pg8::row_rs(SS, row); const u32x2* xr = (const u32x2*)(XB + (size_t)row * D) + lane_p; const f32x4* gr = (const f32x4*)norm_final + lane_p;
        f32x4* o = (f32x4*)(row < NP ? out + OFF_Y + (size_t)row * D : out + OFF_YS + (size_t)(row - NP) * D) + lane_p;
#pragma unroll
        for (int j = 0; j < 4; ++j) { const u32x2 xb = xr[64 * j]; const f32x4 xv = (f32x4){bflo(xb.x), bfhi(xb.x), bflo(xb.y), bfhi(xb.y)}; o[64 * j] = xv * rs * gr[64 * j]; }
    } }

#undef GRID_BAR
}

extern "C" void kernel_launch(void* const* d_in, const int* in_sizes, int n_in, void* d_out, int out_size, void* d_ws, size_t ws_size, hipStream_t stream) {
    static int grid = 0;
    if (grid == 0) {
        if (n_in != 21 || (size_t)out_size != OUT_TOTAL || ws_size < WS_END) { fprintf(stderr, "kernel_launch: unexpected sizes (n_in %d, out %d, ws %zu); nothing launched\n", n_in, out_size, ws_size); grid = -1; return; }
        int dev = 0, cus = 0, per_cu = 0;
        if (hipGetDevice(&dev) != hipSuccess || hipDeviceGetAttribute(&cus, hipDeviceAttributeMultiprocessorCount, dev) != hipSuccess) { fprintf(stderr, "kernel_launch: device query failed\n"); grid = -1; return; }
        if (hipFuncSetAttribute((const void*)nsa_fwd, hipFuncAttributeMaxDynamicSharedMemorySize, LDS_BYTES) != hipSuccess) { fprintf(stderr, "kernel_launch: hipFuncSetAttribute failed\n"); grid = -1; return; }
        if (hipOccupancyMaxActiveBlocksPerMultiprocessor(&per_cu, (const void*)nsa_fwd, NWAVES * 64, LDS_BYTES) != hipSuccess || per_cu < 1)
            fprintf(stderr, "kernel_launch: note: occupancy query reports %d workgroups per CU\n", per_cu);
        (void)hipGetLastError();
        grid = cus;
    }
    if (grid < 0) return;
    if (hipMemsetAsync((char*)d_ws + WS_CTL, 0, CTL_ZERO_BYTES, stream) != hipSuccess) { fprintf(stderr, "kernel_launch: memset failed\n"); return; }
    Args a{};
    for (int i = 0; i < 21; ++i) a.in[i] = (const float*)d_in[i];
    a.out = (float*)d_out; a.ws = (unsigned char*)d_ws;
    hipLaunchKernelGGL(nsa_fwd, dim3(grid), dim3(NWAVES * 64), LDS_BYTES, stream, a);
    const hipError_t le = hipPeekAtLastError();
    if (le != hipSuccess) fprintf(stderr, "kernel_launch: launch failed: %s\n", hipGetErrorName(le));
}
```

```cpp
#include <hip/hip_runtime.h>
#include <cstdio>
#include <cstdint>
#include <cmath>
namespace pg8 {
#define PG8_LAS __attribute__((address_space(3)))
typedef unsigned short bf16_t;
typedef short bf16x8 __attribute__((ext_vector_type(8)));
typedef float f32x4 __attribute__((ext_vector_type(4)));
typedef unsigned u32x4 __attribute__((ext_vector_type(4)));
constexpr int BM = 256, BK = 64, HALF = 128, HTB = HALF * BK * 2  , STAGE_BYTES = 8 * HTB, NXCD = 8, WGM = 8;

__host__ __device__ __forceinline__ int lds_byte(int r, int c) { const int st = (r >> 4) * 2 + (c >> 5), rr = r & 15, cc = c & 31, ob = rr * 64 + cc * 2; return st * 1024 + (ob ^ (((ob >> 9) & 1) << 5)); }
__host__ __device__ __forceinline__ void stage_rc(int b, int& R, int& C) { const int st = b / 1024, sb = b % 1024, swz = sb ^ (((sb >> 9) & 1) << 5); R = (st >> 1) * 16 + swz / 64; C = (st & 1) * 32 + (swz % 64) / 2; }
__host__ __device__ __forceinline__ int perm32(int rho) { const int n = rho >> 4, i = rho & 15; return 8 * (i >> 2) + 4 * n + (i & 3); }

struct Unit { int pm, pn; };
struct Gemm { const bf16_t* A; const bf16_t* Bt; int M, N, K; };

struct StaticOrder {
    int nM, nN, nwg, G, c;
    __host__ __device__ void init(int M, int N, int G_, int c_) { nM = M / BM; nN = N / BM; nwg = nM * nN; G = G_; c = c_; }
    __host__ __device__ bool next(int i, Unit& u) const {
        const long L = (long)i * G + c; if (L >= nwg) return false;
        int wgid = (int)L; { const int q = nwg / NXCD, r = nwg % NXCD, xcd = wgid % NXCD, off = wgid / NXCD; wgid = (xcd < r ? xcd * (q + 1) : r * (q + 1) + (xcd - r) * q) + off; }
        const int nig = WGM * nN, gid = wgid / nig, fm = gid * WGM, gsz = (nM - fm) < WGM ? (nM - fm) : WGM;
        u.pm = fm + ((wgid % nig) % gsz); u.pn = (wgid % nig) / gsz; return true;
    }
    __device__ __forceinline__ void a_ready(const Unit&) const {}
    __device__ __forceinline__ void done(const Unit&) const {}
};

constexpr int ROWS_REAL = 16512, ROWS_PROMPT = 16384;
__device__ __forceinline__ unsigned cvt_pk_bf16(float lo, float hi) { unsigned r; asm volatile("v_cvt_pk_bf16_f32 %0, %1, %2" : "=v"(r) : "v"(lo), "v"(hi)); return r; }
__device__ __forceinline__ void st16_wt(void* p, u32x4 v) { asm volatile("global_store_dwordx4 %0, %1, off sc1\n\ts_nop 1" :: "v"(p), "v"(v) : "memory"); }
__device__ __forceinline__ void st16f_wt(void* p, f32x4 v) { asm volatile("global_store_dwordx4 %0, %1, off sc1\n\ts_nop 1" :: "v"(p), "v"(v) : "memory"); }
typedef unsigned u32x2w __attribute__((ext_vector_type(2)));
__device__ __forceinline__ void st8_wt(void* p, u32x2w v) { asm volatile("global_store_dwordx2 %0, %1, off sc1" :: "v"(p), "v"(v) : "memory"); }
__device__ __forceinline__ float row_rs(const float* SS, int row) {
    const f32x4* p = (const f32x4*)(SS + (size_t)row * 16);
    const f32x4 a = p[0], b = p[1], c = p[2], d = p[3];
    const float s = ((a[0] + a[1]) + (a[2] + a[3])) + ((b[0] + b[1]) + (b[2] + b[3])) + ((c[0] + c[1]) + (c[2] + c[3])) + ((d[0] + d[1]) + (d[2] + d[3]));
    return 1.0f / sqrtf(s * (1.0f / 1024.0f) + 1e-6f);
}
__device__ __forceinline__ void wave_row_rs(const float* SS, int base, int fr, int fq, float (&rs)[2][4]) {
    const int L = fq * 16 + fr; float mine[2]; f32x4 p[2][4];
#pragma unroll
    for (int ai = 0; ai < 2; ++ai) { const f32x4* q = (const f32x4*)(SS + (size_t)(base + ai * HALF + L) * 16);
#pragma unroll
        for (int j = 0; j < 4; ++j) p[ai][j] = q[j]; }
#pragma unroll
    for (int ai = 0; ai < 2; ++ai) { const f32x4 a = p[ai][0], b = p[ai][1], c = p[ai][2], d = p[ai][3];
        const float s = ((a[0] + a[1]) + (a[2] + a[3])) + ((b[0] + b[1]) + (b[2] + b[3])) + ((c[0] + c[1]) + (c[2] + c[3])) + ((d[0] + d[1]) + (d[2] + d[3]));
        mine[ai] = 1.0f / sqrtf(s * (1.0f / 1024.0f) + 1e-6f); }
#pragma unroll
    for (int ai = 0; ai < 2; ++ai)
#pragma unroll
        for (int m = 0; m < 4; ++m) rs[ai][m] = __int_as_float(__builtin_amdgcn_ds_bpermute((m * 16 + fr) * 4, __float_as_int(mine[ai])));
}
__device__ __forceinline__ float gelu_tanh(float x) { const float y = 0.7978845608028654f * (x + 0.044715f * x * x * x); return x * __builtin_amdgcn_rcpf(1.0f + __builtin_amdgcn_exp2f(-2.0f * 1.4426950408889634f * y)); }
struct EpiScaleBf16 {
    static constexpr bool PERM = true, AFTER_DRAIN = false;
    bf16_t* O; int ldc; const float* SS; float* VSS;
    __device__ __forceinline__ void operator()(const f32x4 (&acc)[2][2][4][2], const Unit& u, int wr, int wc, int fr, int fq) const {
        const int row0 = u.pm * BM + wr * 64 + fr, col0 = u.pn * BM + wc * 32 + 8 * fq;
        float rsv[2][4]; wave_row_rs(SS, u.pm * BM + wr * 64, fr, fq, rsv);
#pragma unroll
        for (int ai = 0; ai < 2; ++ai)
#pragma unroll
            for (int m = 0; m < 4; ++m) { const int row = row0 + ai * HALF + m * 16; const float rs = rsv[ai][m]; bf16_t* rowp = O + (size_t)row * ldc + col0;
                float gs = 0.f;
#pragma unroll
                for (int bj = 0; bj < 2; ++bj) { const f32x4 v0 = acc[ai][bj][m][0] * rs, v1 = acc[ai][bj][m][1] * rs;
                    u32x4 w; w.x = cvt_pk_bf16(v0[0], v0[1]); w.y = cvt_pk_bf16(v0[2], v0[3]); w.z = cvt_pk_bf16(v1[0], v1[1]); w.w = cvt_pk_bf16(v1[2], v1[3]);
                    *(u32x4*)(rowp + bj * HALF) = w;
                    if (VSS && u.pn >= 8) {
#pragma unroll
                        for (int i = 0; i < 4; ++i) { const float g0 = gelu_tanh(v0[i]), g1 = gelu_tanh(v1[i]); gs += g0 * g0 + g1 * g1; } } }
                if (VSS && u.pn >= 8) {
                    gs += __int_as_float(__builtin_amdgcn_ds_swizzle(__float_as_int(gs), 0x1F | (16 << 10)));
                    { auto rr = __builtin_amdgcn_permlane32_swap(__float_as_uint(gs), __float_as_uint(gs), false, false); gs = __uint_as_float(rr[0]) + __uint_as_float(rr[1]); }
                    if (fq == 0) VSS[(size_t)row * 8 + (u.pn - 8) * 4 + wc] = gs; } }
    }
};
struct EpiSwiGLU {
    static constexpr bool PERM = true, AFTER_DRAIN = false;
    bf16_t* O; int ldc; const float* SS;
    __device__ __forceinline__ void operator()(const f32x4 (&acc)[2][2][4][2], const Unit& u, int wr, int wc, int fr, int fq) const {
        const int row0 = u.pm * BM + wr * 64 + fr, col0 = u.pn * HALF + wc * 32 + 8 * fq;
        float rsv[2][4]; wave_row_rs(SS, u.pm * BM + wr * 64, fr, fq, rsv);
#pragma unroll
        for (int ai = 0; ai < 2; ++ai)
#pragma unroll
            for (int m = 0; m < 4; ++m) { const int row = row0 + ai * HALF + m * 16; const float rs = rsv[ai][m];
                float o[8];
                const float rs2 = -1.4426950408889634f * rs, rq = rs * rs;
#pragma unroll
                for (int n = 0; n < 2; ++n)
#pragma unroll
                    for (int i = 0; i < 4; ++i) { const float a = acc[ai][0][m][n][i], b = acc[ai][1][m][n][i];
                        const float e = __builtin_amdgcn_exp2f(a * rs2); o[n * 4 + i] = (a * b) * (rq * __builtin_amdgcn_rcpf(1.0f + e)); }
                u32x4 w; w.x = cvt_pk_bf16(o[0], o[1]); w.y = cvt_pk_bf16(o[2], o[3]); w.z = cvt_pk_bf16(o[4], o[5]); w.w = cvt_pk_bf16(o[6], o[7]);
                *(u32x4*)(O + (size_t)row * ldc + col0) = w; }
    }
};
template <bool FIRST> struct EpiResid {
    static_assert(!FIRST, "the residual source is the bf16 stream");
    static constexpr bool PERM = true, AFTER_DRAIN = false;
    const float* xp; const float* xs; bf16_t* XB; float* SS;
    __device__ __forceinline__ void operator()(const f32x4 (&acc)[2][2][4][2], const Unit& u, int wr, int wc, int fr, int fq) const {
        const int row0 = u.pm * BM + wr * 64 + fr, col0 = u.pn * BM + wc * 32 + 8 * fq;
        bf16_t* base = XB + (size_t)row0 * 1024 + col0;
        u32x4 res[2][4][2];
#pragma unroll
        for (int ai = 0; ai < 2; ++ai)
#pragma unroll
            for (int m = 0; m < 4; ++m)
#pragma unroll
                for (int bj = 0; bj < 2; ++bj) res[ai][m][bj] = *(const u32x4*)(base + (size_t)(ai * HALF + m * 16) * 1024 + bj * HALF);
        __builtin_amdgcn_sched_barrier(0);
#pragma unroll
        for (int ai = 0; ai < 2; ++ai)
#pragma unroll
            for (int m = 0; m < 4; ++m) { const int row = row0 + ai * HALF + m * 16;
                float sq = 0.f;
#pragma unroll
                for (int bj = 0; bj < 2; ++bj) { const u32x4 o = res[ai][m][bj];
                    const f32x4 x0 = (f32x4){__uint_as_float(o.x << 16), __uint_as_float(o.x & 0xffff0000u), __uint_as_float(o.y << 16), __uint_as_float(o.y & 0xffff0000u)} + acc[ai][bj][m][0];
                    const f32x4 x1 = (f32x4){__uint_as_float(o.z << 16), __uint_as_float(o.z & 0xffff0000u), __uint_as_float(o.w << 16), __uint_as_float(o.w & 0xffff0000u)} + acc[ai][bj][m][1];
                    u32x4 w; w.x = cvt_pk_bf16(x0[0], x0[1]); w.y = cvt_pk_bf16(x0[2], x0[3]); w.z = cvt_pk_bf16(x1[0], x1[1]); w.w = cvt_pk_bf16(x1[2], x1[3]);
                    *(u32x4*)(base + (size_t)(ai * HALF + m * 16) * 1024 + bj * HALF) = w;
                    sq += ((x0[0] * x0[0] + x0[1] * x0[1]) + (x0[2] * x0[2] + x0[3] * x0[3])) + ((x1[0] * x1[0] + x1[1] * x1[1]) + (x1[2] * x1[2] + x1[3] * x1[3])); }
                sq += __int_as_float(__builtin_amdgcn_ds_swizzle(__float_as_int(sq), 0x1F | (16 << 10)));
                { auto rr = __builtin_amdgcn_permlane32_swap(__float_as_uint(sq), __float_as_uint(sq), false, false); sq = __uint_as_float(rr[0]) + __uint_as_float(rr[1]); }
                if (fq == 0) SS[(size_t)row * 16 + u.pn * 4 + wc] = sq; }
    }
};
struct EpiF32 {
    static constexpr bool PERM = false, AFTER_DRAIN = false;
    float* O; int ldc; const float* SS;
    __device__ __forceinline__ void operator()(const f32x4 (&acc)[2][2][4][2], const Unit& u, int wr, int wc, int fr, int fq) const {
        const int row0 = u.pm * BM + wr * 64 + fr, col0 = u.pn * BM + wc * 32 + 4 * fq;
#pragma unroll
        for (int ai = 0; ai < 2; ++ai)
#pragma unroll
            for (int m = 0; m < 4; ++m) { const int row = row0 + ai * HALF + m * 16; const float rs = SS ? row_rs(SS, row) : 1.0f; float* rowp = O + (size_t)row * ldc + col0;
#pragma unroll
                for (int bj = 0; bj < 2; ++bj)
#pragma unroll
                    for (int n = 0; n < 2; ++n) *(f32x4*)(rowp + bj * HALF + n * 16) = acc[ai][bj][m][n] * rs; }
    }
};

struct EpiNsa {
    static constexpr bool PERM = false, AFTER_DRAIN = false;
    const float* SS; bf16_t *Q, *QR, *KVB; float *G, *out; size_t off_kvp, off_kvs, off_winp, off_wins, kvb_ty; float c2;
    __device__ __forceinline__ void operator()(const f32x4 (&acc)[2][2][4][2], const Unit& u, int wr, int wc, int fr, int fq) const {
        typedef unsigned u32x2v __attribute__((ext_vector_type(2)));
        const int pn = u.pn, row0 = u.pm * BM + wr * 64 + fr, d0 = 16 * (wc & 1) + 4 * fq;
        const bool rope_tile = pn < 4 || pn == 6 || pn == 8;
        f32x4 invf;
#pragma unroll
        for (int i = 0; i < 4; ++i) invf[i] = __builtin_amdgcn_exp2f(-(float)(d0 + i) * 0.41524101186092029f) * 0.15915494309189535f;
        float rsv[2][4]; wave_row_rs(SS, u.pm * BM + wr * 64, fr, fq, rsv);
#pragma unroll
        for (int ai = 0; ai < 2; ++ai)
#pragma unroll
            for (int m = 0; m < 4; ++m) { const int row = row0 + ai * HALF + m * 16;
                if (row < ROWS_REAL) {
                    const float rs = rsv[ai][m]; const bool smp = row >= ROWS_PROMPT; const int pos = smp ? 2048 : (row & 4095); const int nseq = row >> 12;
                    f32x4 cs = (f32x4){1.f, 1.f, 1.f, 1.f}, sn = (f32x4){0.f, 0.f, 0.f, 0.f};
                    if (rope_tile) {
#pragma unroll
                        for (int i = 0; i < 4; ++i) { float rev = (float)pos * invf[i]; rev -= floorf(rev); sn[i] = __builtin_amdgcn_sinf(rev); cs[i] = __builtin_amdgcn_cosf(rev); } }
#pragma unroll
                    for (int bj = 0; bj < 2; ++bj) { const int hb = 2 * bj + (wc >> 1); const f32x4 lo = acc[ai][bj][m][0] * rs, hi = acc[ai][bj][m][1] * rs;
                        if (pn < 4) { const size_t o = (size_t)row * 1024 + (4 * pn + hb) * 64 + d0; const f32x4 ql = lo * c2, qh = hi * c2;
                            u32x2v w; w.x = cvt_pk_bf16(ql[0], ql[1]); w.y = cvt_pk_bf16(ql[2], ql[3]); *(u32x2v*)(Q + o) = w; w.x = cvt_pk_bf16(qh[0], qh[1]); w.y = cvt_pk_bf16(qh[2], qh[3]); *(u32x2v*)(Q + o + 32) = w;
                            const f32x4 rl = ql * cs - qh * sn, rh = qh * cs + ql * sn;
                            w.x = cvt_pk_bf16(rl[0], rl[1]); w.y = cvt_pk_bf16(rl[2], rl[3]); *(u32x2v*)(QR + o) = w; w.x = cvt_pk_bf16(rh[0], rh[1]); w.y = cvt_pk_bf16(rh[2], rh[3]); *(u32x2v*)(QR + o + 32) = w; }
                        else if (pn < 10) { const int ty = pn - 4, g = hb; f32x4 vl = lo, vh = hi;
                            if (rope_tile) { vl = lo * cs - hi * sn; vh = hi * cs + lo * sn; }
                            if (ty < 4) { float* op = out + (smp ? off_kvs + (size_t)(row - ROWS_PROMPT) * 1024 : off_kvp + (size_t)row * 1024) + ty * 256 + g * 64 + d0; *(f32x4*)op = vl; *(f32x4*)(op + 32) = vh; }
                            else if (smp) { float* op = out + off_wins + (size_t)(row - ROWS_PROMPT) * 512 + (ty - 4) * 256 + g * 64 + d0; *(f32x4*)op = vl; *(f32x4*)(op + 32) = vh; }
                            else if (pos >= 4096 - 512) { float* op = out + off_winp + ((size_t)nseq * 512 + (pos - (4096 - 512))) * 512 + (ty - 4) * 256 + g * 64 + d0; *(f32x4*)op = vl; *(f32x4*)(op + 32) = vh; }
                            if (!smp) { bf16_t* kp = KVB + (size_t)ty * kvb_ty + (((size_t)nseq * 4 + g) * 4096 + pos) * 64 + d0;
                                u32x2v w; w.x = cvt_pk_bf16(vl[0], vl[1]); w.y = cvt_pk_bf16(vl[2], vl[3]); *(u32x2v*)kp = w; w.x = cvt_pk_bf16(vh[0], vh[1]); w.y = cvt_pk_bf16(vh[2], vh[3]); *(u32x2v*)(kp + 32) = w; } }
                        else {
#pragma unroll
                            for (int n = 0; n < 2; ++n) { const int j = 128 * bj + 32 * wc + 16 * n + 4 * fq;
                                if (j < 48) { const f32x4 v = acc[ai][bj][m][n] * rs; f32x4 sg;
#pragma unroll
                                    for (int i = 0; i < 4; ++i) sg[i] = __builtin_amdgcn_rcpf(1.0f + __builtin_amdgcn_exp2f(-1.4426950408889634f * v[i]));
                                    *(f32x4*)(G + (size_t)row * 48 + j) = sg; } } }
                    } } }
    }
};

template <class Epi, class Sched, bool ALIGN_EPI = false, bool SP2 = false>
__device__ __forceinline__ void gemm_phase(PG8_LAS unsigned char* lds, const Gemm g, const Sched& S, const Epi& E, const int tid_in) {
    int tid_ = tid_in; asm volatile("" : "+v"(tid_));
    const int tid = tid_, wid = __builtin_amdgcn_readfirstlane(tid >> 6), lane = tid & 63, wr = wid >> 2, wc = wid & 3, fr = lane & 15, fq = lane >> 4;
    const int K = g.K, nt = K / BK;
    unsigned voffA[2], voffB[2];
#pragma unroll
    for (int i = 0; i < 2; ++i) { int R, C; stage_rc(tid * 16 + i * 8192, R, C); const int Rb = Epi::PERM ? ((R & ~31) + perm32(R & 31)) : R;
        voffA[i] = (unsigned)(R * K + C) * 2u; voffB[i] = (unsigned)(Rb * K + C) * 2u; }
    const size_t kstep = (size_t)(BK * 2);
    const size_t hstep = (size_t)HALF * K * 2;
    const size_t tstep = 2 * hstep;
    const unsigned ldsw = (unsigned)wid * 1024u;
    const int aoff = lds_byte(wr * 64 + fr, fq * 8), boff = lds_byte(wc * 32 + fr, fq * 8);
#define PG8_SA(b, h) (((b) * 2 + (h)) * HTB)
#define PG8_SB(b, h) ((4 + (b) * 2 + (h)) * HTB)
#define PG8_STAGE(bufoff, gbase, voff) do { _Pragma("unroll") for (int _i = 0; _i < 2; ++_i) \
        __builtin_amdgcn_global_load_lds((const unsigned*)((const char*)(gbase) + (voff)[_i]), (PG8_LAS unsigned*)(lds + (bufoff) + ldsw + _i * 8192), 16, 0, 0); } while (0)
#define PG8_LDA(dst, b, h) do { _Pragma("unroll") for (int m = 0; m < 4; ++m) _Pragma("unroll") for (int k = 0; k < 2; ++k) dst[m][k] = *(const PG8_LAS bf16x8*)(lds + PG8_SA(b, h) + aoff + m * 2048 + k * 1024); } while (0)
#define PG8_LDB(dst, b, h) do { _Pragma("unroll") for (int n = 0; n < 2; ++n) _Pragma("unroll") for (int k = 0; k < 2; ++k) dst[n][k] = *(const PG8_LAS bf16x8*)(lds + PG8_SB(b, h) + boff + n * 2048 + k * 1024); } while (0)
#define PG8_MMA(ai, bj, At, Bt) do { __builtin_amdgcn_s_setprio(1); _Pragma("unroll") for (int m = 0; m < 4; ++m) _Pragma("unroll") for (int n = 0; n < 2; ++n) _Pragma("unroll") for (int k = 0; k < 2; ++k) \
        acc[ai][bj][m][n] = __builtin_amdgcn_mfma_f32_16x16x32_bf16(Bt[n][k], At[m][k], acc[ai][bj][m][n], 0, 0, 0); __builtin_amdgcn_s_setprio(0); } while (0)
#define PG8_WAIT_V(n) asm volatile("s_waitcnt vmcnt(" #n ")" ::: "memory")
#define PG8_WAIT_L(n) asm volatile("s_waitcnt lgkmcnt(" #n ")" ::: "memory")
#define PG8_BAR __builtin_amdgcn_s_barrier()
#define PG8_SCHED __builtin_amdgcn_sched_barrier(0)
    Unit cur, nxt; int ui = 0;
    if (!S.next(0, cur)) return;
    f32x4 acc[2][2][4][2];
#pragma unroll
    for (int a = 0; a < 2; ++a)
#pragma unroll
        for (int b = 0; b < 2; ++b)
#pragma unroll
            for (int m = 0; m < 4; ++m)
#pragma unroll
                for (int n = 0; n < 2; ++n) acc[a][b][m][n] = (f32x4){0.f, 0.f, 0.f, 0.f};
    bf16x8 At[4][2], B0[2][2], B1[2][2];
    const char* cA = (const char*)g.A + (size_t)cur.pm * tstep; const char* cB = (const char*)g.Bt + (size_t)cur.pn * tstep;
    S.a_ready(cur);
    if constexpr (SP2) {
        PG8_STAGE(PG8_SB(0, 0), cB, voffB); PG8_STAGE(PG8_SB(0, 1), cB + hstep, voffB); PG8_STAGE(PG8_SA(0, 0), cA, voffA); PG8_STAGE(PG8_SA(0, 1), cA + hstep, voffA);
        if (wr == 1) PG8_BAR;
        PG8_WAIT_V(2); PG8_BAR;
        PG8_STAGE(PG8_SB(1, 0), cB + kstep, voffB); PG8_STAGE(PG8_SA(1, 0), cA + kstep, voffA); PG8_STAGE(PG8_SB(1, 1), cB + hstep + kstep, voffB);
        PG8_WAIT_V(6); PG8_BAR;
    } else {
        PG8_STAGE(PG8_SB(0, 0), cB, voffB); PG8_STAGE(PG8_SA(0, 0), cA, voffA); PG8_STAGE(PG8_SB(0, 1), cB + hstep, voffB); PG8_STAGE(PG8_SA(0, 1), cA + hstep, voffA);
        if (wr == 1) PG8_BAR;
        PG8_WAIT_V(4); PG8_BAR;
        PG8_STAGE(PG8_SB(1, 0), cB + kstep, voffB); PG8_STAGE(PG8_SA(1, 0), cA + kstep, voffA); PG8_STAGE(PG8_SB(1, 1), cB + hstep + kstep, voffB);
        PG8_WAIT_V(6); PG8_BAR;
    }
    for (;;) {
        const bool has_next = S.next(ui + 1, nxt);
        const char* nA = has_next ? (const char*)g.A + (size_t)nxt.pm * tstep : cA; const char* nB = has_next ? (const char*)g.Bt + (size_t)nxt.pn * tstep : cB;
        for (int t = 0; t < nt; t += 2) {
            const bool last = (t == nt - 2);
            const char* a1 = cA + (size_t)(t + 1) * kstep;
            const char* a2 = last ? nA : cA + (size_t)(t + 2) * kstep; const char* b2 = last ? nB : cB + (size_t)(t + 2) * kstep;
            const char* a3 = a2 + kstep; const char* b3 = b2 + kstep;
            if (last && has_next) S.a_ready(nxt);
            if constexpr (SP2) {
            PG8_LDB(B0, 0, 0); PG8_LDB(B1, 0, 1); PG8_SCHED; PG8_LDA(At, 0, 0); PG8_STAGE(PG8_SA(1, 1), a1 + hstep, voffA);
            PG8_WAIT_V(8); PG8_WAIT_L(0); PG8_BAR; PG8_MMA(0, 0, At, B0); PG8_MMA(0, 1, At, B1); PG8_BAR; PG8_SCHED;
            PG8_LDA(At, 0, 1); PG8_STAGE(PG8_SB(0, 0), b2, voffB); PG8_STAGE(PG8_SB(0, 1), b2 + hstep, voffB); PG8_STAGE(PG8_SA(0, 0), a2, voffA);
            PG8_WAIT_V(8); PG8_WAIT_L(0); PG8_BAR; PG8_MMA(1, 0, At, B0); PG8_MMA(1, 1, At, B1); PG8_BAR; PG8_SCHED;
            PG8_LDB(B0, 1, 0); PG8_LDB(B1, 1, 1); PG8_SCHED; PG8_LDA(At, 1, 0); PG8_STAGE(PG8_SA(0, 1), a2 + hstep, voffA);
            PG8_WAIT_V(8); PG8_WAIT_L(0); PG8_BAR; PG8_MMA(0, 0, At, B0); PG8_MMA(0, 1, At, B1); PG8_BAR; PG8_SCHED;
            PG8_LDA(At, 1, 1); PG8_STAGE(PG8_SB(1, 0), b3, voffB); PG8_STAGE(PG8_SB(1, 1), b3 + hstep, voffB); PG8_STAGE(PG8_SA(1, 0), a3, voffA);
            PG8_WAIT_V(8); PG8_WAIT_L(0); PG8_BAR; PG8_MMA(1, 0, At, B0); PG8_MMA(1, 1, At, B1); PG8_BAR; PG8_SCHED;
            } else {
            PG8_LDB(B0, 0, 0); PG8_SCHED; PG8_LDA(At, 0, 0); PG8_STAGE(PG8_SA(1, 1), a1 + hstep, voffA);
            PG8_WAIT_L(8); PG8_BAR; PG8_WAIT_L(0); PG8_MMA(0, 0, At, B0); PG8_BAR; PG8_SCHED;
            PG8_LDB(B1, 0, 1); PG8_STAGE(PG8_SB(0, 0), b2, voffB);
            PG8_BAR; PG8_WAIT_L(0); PG8_MMA(0, 1, At, B1); PG8_BAR;
            PG8_LDA(At, 0, 1); PG8_STAGE(PG8_SA(0, 0), a2, voffA);
            PG8_BAR; PG8_WAIT_L(0); PG8_MMA(1, 0, At, B0); PG8_BAR; PG8_SCHED;
            PG8_STAGE(PG8_SB(0, 1), b2 + hstep, voffB);
            PG8_WAIT_V(6); PG8_BAR; PG8_MMA(1, 1, At, B1); PG8_BAR;
            PG8_LDB(B0, 1, 0); PG8_SCHED; PG8_LDA(At, 1, 0); PG8_STAGE(PG8_SA(0, 1), a2 + hstep, voffA);
            PG8_WAIT_L(8); PG8_BAR; PG8_WAIT_L(0); PG8_MMA(0, 0, At, B0); PG8_BAR; PG8_SCHED;
            PG8_LDB(B1, 1, 1); PG8_STAGE(PG8_SB(1, 0), b3, voffB);
            PG8_BAR; PG8_WAIT_L(0); PG8_MMA(0, 1, At, B1); PG8_BAR;
            PG8_LDA(At, 1, 1); PG8_STAGE(PG8_SA(1, 0), a3, voffA);
            PG8_BAR; PG8_WAIT_L(0); PG8_MMA(1, 0, At, B0); PG8_BAR; PG8_SCHED;
            PG8_STAGE(PG8_SB(1, 1), b3 + hstep, voffB);
            PG8_WAIT_V(6); PG8_BAR; PG8_MMA(1, 1, At, B1); PG8_BAR;
            }
        }
        if constexpr (ALIGN_EPI) { if (wr == 0) PG8_BAR; }
        if constexpr (!Epi::AFTER_DRAIN) { E(acc, cur, wr, wc, fr, fq); S.done(cur); }
        if (!has_next) break;
#pragma unroll
        for (int a = 0; a < 2; ++a)
#pragma unroll
            for (int b = 0; b < 2; ++b)
#pragma unroll
                for (int m = 0; m < 4; ++m)
#pragma unroll
                    for (int n = 0; n < 2; ++n) acc[a][b][m][n] = (f32x4){0.f, 0.f, 0.f, 0.f};
        cur = nxt; cA = nA; cB = nB; ++ui;
        if constexpr (ALIGN_EPI) { if (wr == 1) PG8_BAR; }
    }
    PG8_WAIT_V(0);
    if constexpr (!ALIGN_EPI) { if (wr == 0) PG8_BAR; }
    PG8_BAR;
    if constexpr (Epi::AFTER_DRAIN) { E.fused(acc, cur, wr, wc, fr, fq, lds, wid, lane); S.done(cur); }
#undef PG8_SA
#undef PG8_SB
#undef PG8_STAGE
#undef PG8_LDA
#undef PG8_LDB
#undef PG8_MMA
#undef PG8_WAIT_V
#undef PG8_WAIT_L
#undef PG8_BAR
#undef PG8_SCHED
}
}

constexpr int NWAVES = 8;
constexpr int D = 1024, SEQ = 4096, NBATCH = 4, NP = NBATCH * SEQ, NSMP = 128, MR = NP + NSMP, MP = 16640;
constexpr int N_IN0 = 2560, DFF = 2816, N_FF2 = 2 * DFF, N_IN1 = 2608, N_IN1P = 2816;
constexpr int PAST = 2048;
constexpr float RMS_EPS = 1e-6f;
constexpr float C2 = 0.125f * 1.4426950408889634f;
static_assert(pg8::ROWS_REAL == MR && pg8::ROWS_PROMPT == NP, "row constants");
constexpr size_t OFF_Y = 0, OFF_YS = 16777216, OFF_CSP = 16908288, OFF_CSS = 16912384, OFF_CVS = 17043456, OFF_KVP = 17108992, OFF_KVS = 33886208, OFF_WINP = 34017280, OFF_WINS = 35065856, OUT_TOTAL = 35131392;
constexpr size_t MiB = 1u << 20, HMiB = 1u << 19;
constexpr size_t WS_CTL = 0, CTL_ZERO_BYTES = 1 * MiB;
constexpr size_t WS_W0IN = 2 * MiB, WS_W0OUT = 7 * MiB, WS_WFI0 = 9 * MiB, WS_WFI1 = 20 * MiB, WS_WFO0 = 31 * MiB, WS_WFO1 = 36 * MiB + HMiB, WS_W1IN = 42 * MiB, WS_W1OUT = 47 * MiB + HMiB, WS_WCMP = 49 * MiB + HMiB;
constexpr size_t WS_SS = 50 * MiB, WS_CBIAS = 52 * MiB, WS_VSS = 52 * MiB + 65536, WS_G = 53 * MiB;
constexpr size_t WS_X = 64 * MiB, WS_XB = 129 * MiB, WS_H0 = 162 * MiB, WS_YC = 244 * MiB, WS_ACT = 277 * MiB, WS_H1 = 367 * MiB, WS_Q = 546 * MiB, WS_QR = 579 * MiB, WS_O = 612 * MiB;
constexpr size_t WS_CMPA = 645 * MiB, WS_KVB = 901 * MiB, WS_PQ = 949 * MiB, WS_END = 1085 * MiB;
constexpr int CMP_ROWS_S = 131072, CMP_ROWS = CMP_ROWS_S + 8192;
constexpr size_t KVB_TY = (size_t)16 * SEQ * 64;
static_assert(WS_CMPA + (size_t)CMP_ROWS_S * 1024 * 2 == WS_KVB, "the prompt k_cmp/v_cmp rows follow the sample rows");
constexpr int CW_TMO = 0, CW_BAR = 4096, CW_FLAG = 16384;
constexpr int RING_OFF = 0, RING_BYTES = 131072;
constexpr int LDSCTL_OFF = 133120, MISC_OFF = LDSCTL_OFF + 320;
constexpr int LDS_BYTES = 147456;
static_assert(MISC_OFF + 128 <= LDS_BYTES, "LDS map");

#define GAS __attribute__((address_space(1)))
#define LAS __attribute__((address_space(3)))
typedef unsigned short bf16;
typedef unsigned u32x4 __attribute__((ext_vector_type(4)));
typedef unsigned u32x2 __attribute__((ext_vector_type(2)));
typedef float f32x4 __attribute__((ext_vector_type(4)));
typedef float f32x16 __attribute__((ext_vector_type(16)));
typedef short bf16x8 __attribute__((ext_vector_type(8)));
typedef short s16x4 __attribute__((ext_vector_type(4)));
typedef GAS unsigned gu32;
#define RLX_AGENT __ATOMIC_RELAXED, __HIP_MEMORY_SCOPE_AGENT
#define LDS_WAIT() asm volatile("s_waitcnt lgkmcnt(0)" ::: "memory")
#define VM_WAIT() asm volatile("s_waitcnt vmcnt(0)" ::: "memory")
typedef float f32x2_t __attribute__((ext_vector_type(2))); typedef __bf16 bf16x2_t __attribute__((ext_vector_type(2)));
__device__ __forceinline__ unsigned pk2(float lo, float hi) { f32x2_t v = {lo, hi}; bf16x2_t b = __builtin_convertvector(v, bf16x2_t); return __builtin_bit_cast(unsigned, b); }
__device__ __forceinline__ float bflo(unsigned w) { return __uint_as_float(w << 16); }
__device__ __forceinline__ float bfhi(unsigned w) { return __uint_as_float(w & 0xffff0000u); }
__device__ __forceinline__ float bf1(bf16 b) { return __uint_as_float((unsigned)b << 16); }
template <int CTRL> __device__ __forceinline__ float dpp_mov(float v) { return __int_as_float(__builtin_amdgcn_update_dpp(0, __float_as_int(v), CTRL, 0xF, 0xF, true)); }
template <int X> __device__ __forceinline__ float lane_xor(float v) { static_assert(X >= 1 && X < 32, "xor within a 32-lane half");
    if (X == 1) return dpp_mov<0xB1>(v); if (X == 2) return dpp_mov<0x4E>(v);
    return __int_as_float(__builtin_amdgcn_ds_swizzle(__float_as_int(v), 0x1F | (X << 10))); }
__device__ __forceinline__ float sum16(float v) { v += dpp_mov<0xB1>(v); v += dpp_mov<0x4E>(v); v += dpp_mov<0x141>(v); v += dpp_mov<0x140>(v); return v; }
__device__ __forceinline__ float max16(float v) { v = fmaxf(v, dpp_mov<0xB1>(v)); v = fmaxf(v, dpp_mov<0x4E>(v)); v = fmaxf(v, dpp_mov<0x141>(v)); v = fmaxf(v, dpp_mov<0x140>(v)); return v; }
__device__ __forceinline__ float xhalf_sum(float v) { auto rr = __builtin_amdgcn_permlane32_swap(__float_as_uint(v), __float_as_uint(v), false, false); return __uint_as_float(rr[0]) + __uint_as_float(rr[1]); }
__device__ __forceinline__ float xhalf_max(float v) { auto rr = __builtin_amdgcn_permlane32_swap(__float_as_uint(v), __float_as_uint(v), false, false); return fmaxf(__uint_as_float(rr[0]), __uint_as_float(rr[1])); }
__device__ __forceinline__ float xhalf_other(float v, int hh) { auto rr = __builtin_amdgcn_permlane32_swap(__float_as_uint(v), __float_as_uint(v), false, false); return __uint_as_float(hh ? rr[0] : rr[1]); }
__device__ __forceinline__ float wave_sum(float v) { v = sum16(v); v += lane_xor<16>(v); return xhalf_sum(v); }
__device__ __forceinline__ float wave_max(float v) { v = max16(v); v = fmaxf(v, lane_xor<16>(v)); return xhalf_max(v); }
__device__ __forceinline__ int fresh_tid(int wave_s) { int l; asm volatile("v_mbcnt_lo_u32_b32 %0, -1, 0\n\tv_mbcnt_hi_u32_b32 %0, -1, %0" : "=v"(l)); return wave_s * 64 + l; }
__device__ __forceinline__ float gelu_t(float x) {
    const float y = 0.7978845608028654f * (x + 0.044715f * x * x * x);
    const float e = __builtin_amdgcn_exp2f(-2.0f * 1.4426950408889634f * y);
    return x * __builtin_amdgcn_rcpf(1.0f + e);
}
__device__ __forceinline__ float sigmoid_f(float x) { return __builtin_amdgcn_rcpf(1.0f + __builtin_amdgcn_exp2f(-1.4426950408889634f * x)); }
typedef short v4i16_t __attribute__((ext_vector_type(4)));
__device__ __forceinline__ s16x4 tr16(const LAS unsigned char* p) { return __builtin_bit_cast(s16x4, __builtin_amdgcn_ds_read_tr16_b64_v4i16((LAS v4i16_t*)p)); }
__device__ __forceinline__ bf16x8 cat8(s16x4 lo, s16x4 hi) { return (bf16x8){lo[0], lo[1], lo[2], lo[3], hi[0], hi[1], hi[2], hi[3]}; }
__device__ __forceinline__ int crow(int r, int h) { return (r & 3) + 8 * (r >> 2) + 4 * h; }
__device__ __forceinline__ int kappa(int i) { return 16 * ((i >> 2) & 1) + (i & 3) + 4 * (i >> 3); }
__device__ __forceinline__ float max3f(float a, float b, float c) { float r; asm("v_max3_f32 %0, %1, %2, %3" : "=v"(r) : "v"(a), "v"(b), "v"(c)); return r; }
#define MFMA32(a, b, c) __builtin_amdgcn_mfma_f32_32x32x16_bf16((a), (b), (c), 0, 0, 0)

#define XB_TMO      128
#define XB_XCNT(j)  (256  + 64 * (j))
#define XB_XSUB(j)  (1280 + 64 * (j))
#define XB_XGEN(j)  (2304 + 64 * (j))
#define XB_TOP      3328
#define XB_TOPGEN   3392
#define XCD_BAR_WORDS 3456
#define XB_SPIN_CAP (1u << 18)

__device__ __forceinline__ unsigned xb_ld(unsigned* p)              { return __hip_atomic_load(p, __ATOMIC_RELAXED, __HIP_MEMORY_SCOPE_AGENT); }
__device__ __forceinline__ unsigned xb_add(unsigned* p, unsigned v) { return __hip_atomic_fetch_add(p, v, __ATOMIC_RELAXED, __HIP_MEMORY_SCOPE_AGENT); }
__device__ __forceinline__ unsigned xb_xcc_id() { return (unsigned)__builtin_amdgcn_s_getreg((3 << 11) | 20) & 0xFu; }
#define XB_SPIN(cond, bar) do { unsigned _sp = 0; while (cond) { __builtin_amdgcn_s_sleep(1); \
    if ((++_sp & 255u) == 0u) { if (xb_ld(&(bar)[XB_TMO])) break; if (_sp > XB_SPIN_CAP) { atomicAdd(&(bar)[XB_TMO], 1u); break; } } } } while (0)

struct XcdBarrier {
    unsigned* bar; unsigned x;
    volatile LAS unsigned* st;
};

__device__ __forceinline__ XcdBarrier xcd_barrier_post(unsigned* bar, volatile LAS unsigned* st) {
    XcdBarrier b; b.bar = bar; b.x = xb_xcc_id(); b.st = st;
    if (threadIdx.x == 0) (void)xb_add(&bar[XB_XCNT(b.x)], 1u);
    return b;
}
__device__ __forceinline__ void xcd_barrier_complete(unsigned* bar, unsigned x, unsigned& nloc, unsigned& nx) {
    const unsigned G = gridDim.x * gridDim.y * gridDim.z;
    unsigned sum, cnt, mine, sp = 0u;
    for (;;) {
        sum = 0u; cnt = 0u; mine = 0u;
#pragma unroll
        for (unsigned j = 0; j < 16; ++j) { const unsigned c = xb_ld(&bar[XB_XCNT(j)]); sum += c; cnt += (c > 0u) ? 1u : 0u; mine = (j == x) ? c : mine; }
        if (sum == G) break;
        __builtin_amdgcn_s_sleep(1);
        if ((++sp & 255u) == 0u) { if (xb_ld(&bar[XB_TMO])) break; if (sp > XB_SPIN_CAP) { atomicAdd(&bar[XB_TMO], 1u); break; } }
    }
    nloc = mine > 0u ? mine : 1u; nx = cnt > 0u ? cnt : 1u;
}

__device__ __forceinline__ void xcd_barrier(const XcdBarrier& b) {
    asm volatile("s_waitcnt vmcnt(0)" ::: "memory");
    __syncthreads();
    if (threadIdx.x == 0) {
        unsigned* bar = b.bar;
        __builtin_amdgcn_s_waitcnt(0);
        unsigned nloc = b.st[0], nx = b.st[1];
        if (nloc == 0u) { xcd_barrier_complete(bar, b.x, nloc, nx); b.st[0] = nloc; b.st[1] = nx; }
        const unsigned old = xb_add(&bar[XB_XSUB(b.x)], 1u);
        const unsigned gen = old / nloc;
        if (old + 1u == (gen + 1u) * nloc) {
            __builtin_amdgcn_fence(__ATOMIC_RELEASE, "agent");
            asm volatile("s_waitcnt vmcnt(0)" ::: "memory");
            const unsigned og = xb_add(&bar[XB_TOP], 1u);
            const unsigned tg = og / nx;
            if (og + 1u == (tg + 1u) * nx) xb_add(&bar[XB_TOPGEN], 1u);
            else XB_SPIN(xb_ld(&bar[XB_TOPGEN]) == tg, bar);
            __builtin_amdgcn_fence(__ATOMIC_ACQUIRE, "agent");
            xb_add(&bar[XB_XGEN(b.x)], 1u);
            asm volatile("s_waitcnt vmcnt(0)" ::: "memory");
        } else {
            XB_SPIN(xb_ld(&bar[XB_XGEN(b.x)]) == gen, bar);
            __builtin_amdgcn_fence(__ATOMIC_ACQUIRE, "agent");
            asm volatile("s_waitcnt vmcnt(0)" ::: "memory");
        }
    }
    __syncthreads();
}

struct TrItem { const float* W; const float* g; bf16* WT; int ldw, k0, n0, nvalid, K, drow0, drow1; };
struct P0Args { const float *xp, *xs, *norm_mix, *norm_ffn, *w_in0, *w_out0, *w_in1, *pe_cmp, *w_cmp, *w_out1, *w_ffn_in, *w_ffn_out; unsigned char* ws; };
constexpr int TR_IN0 = 16 * 80, TR_OUT = 16 * 32, TR_FI = 16 * 176, TR_FO = 44 * 32, TR_IN1 = 16 * 82, TR_CMP = 128, TR_NITEMS = TR_IN0 + TR_OUT + 2 * TR_FI + 2 * TR_FO + TR_IN1 + TR_OUT + TR_CMP;
__device__ __forceinline__ void tr_decode(const P0Args& a, int r, TrItem& t) {
    unsigned char* ws = a.ws; t.g = nullptr; t.nvalid = 32; t.drow1 = -1;
    if (r < TR_IN0) { t.W = a.w_in0; t.ldw = N_IN0; t.k0 = 64 * (r / 80); t.n0 = 32 * (r % 80); t.WT = (bf16*)(ws + WS_W0IN); t.K = D; t.drow0 = t.n0; t.g = a.norm_mix; }
    else if ((r -= TR_IN0) < TR_OUT) { t.W = a.w_out0; t.ldw = D; t.k0 = 64 * (r / 32); t.n0 = 32 * (r % 32); t.WT = (bf16*)(ws + WS_W0OUT); t.K = D; t.drow0 = t.n0; }
    else if ((r -= TR_OUT) < 2 * TR_FI) { const int l = r / TR_FI; r -= l * TR_FI; const int n0 = 32 * (r % 176); const int nn = n0 < DFF ? n0 : n0 - DFF;
        t.W = a.w_ffn_in + (size_t)l * D * N_FF2; t.ldw = N_FF2; t.k0 = 64 * (r / 176); t.n0 = n0; t.WT = (bf16*)(ws + (l ? WS_WFI1 : WS_WFI0)); t.K = D;
        t.drow0 = 256 * (nn / 128) + (nn % 128) + (n0 < DFF ? 0 : 128); t.g = a.norm_ffn + l * D; }
    else if ((r -= 2 * TR_FI) < 2 * TR_FO) { const int l = r / TR_FO; r -= l * TR_FO;
        t.W = a.w_ffn_out + (size_t)l * DFF * D; t.ldw = D; t.k0 = 64 * (r / 32); t.n0 = 32 * (r % 32); t.WT = (bf16*)(ws + (l ? WS_WFO1 : WS_WFO0)); t.K = DFF; t.drow0 = t.n0; }
    else if ((r -= 2 * TR_FO) < TR_IN1) { const int n0 = 32 * (r % 82);
        const int hb0 = n0 & ~63, d16 = (n0 & 63) >> 4;
        t.W = a.w_in1; t.ldw = N_IN1; t.k0 = 64 * (r / 82); t.n0 = n0; t.nvalid = (N_IN1 - n0) < 32 ? (N_IN1 - n0) : 32; t.WT = (bf16*)(ws + WS_W1IN); t.K = D; t.g = a.norm_mix + D;
        t.drow0 = n0 < 2560 ? hb0 + 32 * (d16 & 1) + 16 * (d16 >> 1) : n0; t.drow1 = n0 < 2560 ? hb0 + 32 * ((d16 + 1) & 1) + 16 * ((d16 + 1) >> 1) : n0 + 16; }
    else if ((r -= TR_IN1) < TR_OUT) { t.W = a.w_out1; t.ldw = D; t.k0 = 64 * (r / 32); t.n0 = 32 * (r % 32); t.WT = (bf16*)(ws + WS_W1OUT); t.K = D; t.drow0 = t.n0; }
    else { r -= TR_OUT; const int th = r >> 5, q = r & 31;
        t.W = a.w_cmp + (size_t)th * 1024 * 64; t.ldw = 64; t.k0 = 64 * (q >> 1); t.n0 = 32 * (q & 1); t.WT = (bf16*)(ws + WS_WCMP); t.K = 1024; t.drow0 = th * 64 + 32 * (q & 1); }
    if (t.drow1 < 0) t.drow1 = t.drow0 + 16;
}
__device__ __forceinline__ void tr_load(const TrItem& t, float (&v)[32], int lane) {
    const int n = lane & 31, kh = lane >> 5; const float* wp = t.W + (size_t)(t.k0 + kh) * t.ldw + t.n0 + (n < t.nvalid ? n : 0);
#pragma unroll
    for (int i = 0; i < 32; ++i) v[i] = wp[(size_t)(2 * i) * t.ldw];
}
__device__ __forceinline__ void tr_finish(const TrItem& t, const float (&v)[32], LAS float* scr, int lane) {
    const int n = lane & 31, kh = lane >> 5;
#pragma unroll
    for (int i = 0; i < 32; ++i) { float x = n < t.nvalid ? v[i] : 0.f; if (t.g) x *= t.g[t.k0 + 2 * i + kh]; scr[(2 * i + kh) * 33 + n] = x; }
    LDS_WAIT(); asm volatile("" ::: "memory");
    const int c = lane & 7;
#pragma unroll
    for (int j = 0; j < 4; ++j) { const int nn = (lane >> 3) + 8 * j; const LAS float* s = scr + (8 * c) * 33 + nn;
        u32x4 o; o.x = pk2(s[0 * 33], s[1 * 33]); o.y = pk2(s[2 * 33], s[3 * 33]); o.z = pk2(s[4 * 33], s[5 * 33]); o.w = pk2(s[6 * 33], s[7 * 33]);
        const int dr = nn < 16 ? t.drow0 + nn : t.drow1 + nn - 16;
        *(u32x4*)(t.WT + (size_t)dr * t.K + t.k0 + 8 * c) = o; }
    LDS_WAIT(); asm volatile("" ::: "memory");
}
constexpr int TRG_N0 = TR_IN0, TRG_N1 = TR_OUT + TR_FI, TRG_N2 = TR_FO + TR_IN1 + TR_CMP, TRG_N3 = TR_FO + TR_OUT, TRG_N4 = TR_FI / 2, TRG_N5 = TR_FI - TRG_N4;
static_assert(TRG_N0 + TRG_N1 + TRG_N2 + TRG_N3 + TRG_N4 + TRG_N5 == TR_NITEMS, "transpose groups");
__device__ __forceinline__ int tr_group_item(int grp, int j) {
    constexpr int O_OUT0 = TR_IN0, O_FI0 = O_OUT0 + TR_OUT, O_FI1 = O_FI0 + TR_FI, O_FO0 = O_FI1 + TR_FI, O_FO1 = O_FO0 + TR_FO, O_IN1 = O_FO1 + TR_FO, O_OUT1 = O_IN1 + TR_IN1, O_CMP = O_OUT1 + TR_OUT;
    if (grp == 0) return j;
    if (grp == 4) return O_FI1 + j;
    if (grp == 5) return O_FI1 + TRG_N4 + j;
    if (grp == 1) return O_OUT0 + j;
    if (grp == 2) { if (j < TR_FO) return O_FO0 + j; j -= TR_FO; if (j < TR_IN1) return O_IN1 + j; return O_CMP + (j - TR_IN1); }
    return j < TR_FO ? O_FO1 + j : O_OUT1 + (j - TR_FO);
}
__device__ __forceinline__ void tr_run(const P0Args& a, int grp, int nitems, int wk, int nwk, LAS float* scr, int lane) {
    if (wk < nitems) {
        TrItem A, B; float va[32], vb[32];
        tr_decode(a, tr_group_item(grp, wk), A); tr_load(A, va, lane);
#pragma unroll 1
        for (int it = wk; it < nitems; it += 2 * nwk) {
            const int i1 = it + nwk; const bool h1 = i1 < nitems; tr_decode(a, tr_group_item(grp, h1 ? i1 : it), B); tr_load(B, vb, lane);
            __builtin_amdgcn_sched_barrier(0);
            tr_finish(A, va, scr, lane);
            const int i2 = it + 2 * nwk; const bool h2 = i2 < nitems; tr_decode(a, tr_group_item(grp, h2 ? i2 : it), A); tr_load(A, va, lane);
            __builtin_amdgcn_sched_barrier(0);
            if (h1) tr_finish(B, vb, scr, lane);
        }
    }
}
__device__ __forceinline__ void p0_prologue(const P0Args& a, LAS unsigned char* lds, int gw, int NGW, int wave, int lane) {
    LAS float* scr = (LAS float*)(lds + RING_OFF + wave * 16384);
    unsigned char* ws = a.ws;
    tr_run(a, 0, TRG_N0, gw, NGW, scr, lane);
    { u32x4* z = (u32x4*)(ws + WS_W1IN + (size_t)2624 * D * 2); const int nz = (N_IN1P - 2624) * D * 2 / 16;
      for (int i = gw * 64 + lane; i < nz; i += NGW * 64) z[i] = (u32x4){0u, 0u, 0u, 0u}; }
    for (int it = gw; it < 64 * 32; it += NGW) if ((it & 31) == 0) { const int ci = it >> 5, type = ci >> 5, chunk = ci & 31; float s = 0.f;
        const float* wp = a.w_cmp + ((size_t)type * 2048 + chunk * 64) * 64 + lane; const float* pp = a.pe_cmp + type * 2048 + chunk * 64;
#pragma unroll 16
        for (int kk = 0; kk < 64; ++kk) s += pp[kk] * wp[(size_t)kk * 64];
        ((float*)(ws + WS_CBIAS + 4096))[ci * 64 + lane] = s; }
    for (int row0 = 4 * gw; row0 < MP; row0 += 4 * NGW) {
        f32x4 v[4][4];
#pragma unroll
        for (int rr = 0; rr < 4; ++rr) { const int row = row0 + rr; const int rc = row < MR ? row : MR - 1;
            const f32x4* xr = (const f32x4*)(rc < NP ? a.xp + (size_t)rc * D : a.xs + (size_t)(rc - NP) * D) + lane;
#pragma unroll
            for (int j = 0; j < 4; ++j) v[rr][j] = xr[64 * j]; }
#pragma unroll
        for (int rr = 0; rr < 4; ++rr) { const int row = row0 + rr; const bool real = row < MR;
            unsigned long long* o8 = (unsigned long long*)(ws + WS_XB + (size_t)row * D * 2) + lane; float* ss = (float*)(ws + WS_SS) + (size_t)row * 16;
            float s = 0.f;
#pragma unroll
            for (int j = 0; j < 4; ++j) { if (!real) v[rr][j] = (f32x4){0.f, 0.f, 0.f, 0.f}; s += (v[rr][j][0] * v[rr][j][0] + v[rr][j][1] * v[rr][j][1]) + (v[rr][j][2] * v[rr][j][2] + v[rr][j][3] * v[rr][j][3]); }
            s = wave_sum(s);
#pragma unroll
            for (int j = 0; j < 4; ++j) o8[64 * j] = (unsigned long long)pk2(v[rr][j][0], v[rr][j][1]) | ((unsigned long long)pk2(v[rr][j][2], v[rr][j][3]) << 32);
            if (lane < 16) ss[lane] = lane == 0 ? s : 0.f; }
    }
}

constexpr int P2_PITCH = 272, P2_VN = 0, P2_WT = 128 * P2_PITCH, P2_MX = 2 * 128 * P2_PITCH;
struct P2Args { const bf16* H0; bf16* YC; const float *conv_w, *norm_v, *w_spatial, *b_spatial, *state_conv, *VSS; float* out; };
__device__ __forceinline__ void p2_unit(const P2Args& a, int u, LAS unsigned char* lds, int tid) {
    asm volatile("" : "+v"(tid));
    const int n = u >> 7, c = (u >> 2) & 31, hd = u & 3;
    const int lane = tid & 63, w = tid >> 6;
    const size_t R0 = (size_t)n * SEQ + c * 128;
    {
        const int cg = tid & 15, ts = tid >> 4, ch = hd * 128 + cg * 8;
        float w0[8], w1[8], w2[8];
#pragma unroll
        for (int k = 0; k < 8; ++k) { w0[k] = a.conv_w[ch + k]; w1[k] = a.conv_w[512 + ch + k]; w2[k] = a.conv_w[1024 + ch + k]; }
#pragma unroll 2
        for (int j = 0; j < 4; ++j) { const int tok = ts + 32 * j, p = c * 128 + tok; const size_t row = R0 + tok; const bf16* hr = a.H0 + row * N_IN0;
            const u32x4 bg = *(const u32x4*)(hr + ch), c0 = *(const u32x4*)(hr + 512 + ch), h0 = *(const u32x4*)(hr + 1024 + ch);
            u32x4 c1 = (u32x4){0u, 0u, 0u, 0u}, h1 = c1, c2 = c1, h2 = c1;
            if (p >= 1) { c1 = *(const u32x4*)(hr - N_IN0 + 512 + ch); h1 = *(const u32x4*)(hr - N_IN0 + 1024 + ch); }
            if (p >= 2) { c2 = *(const u32x4*)(hr - 2 * N_IN0 + 512 + ch); h2 = *(const u32x4*)(hr - 2 * N_IN0 + 1024 + ch); }
            float z0[8], y[8];
#pragma unroll
            for (int k = 0; k < 4; ++k) {
                const float zz0a = bflo(c0[k]) * bflo(h0[k]), zz0b = bfhi(c0[k]) * bfhi(h0[k]);
                const float zz1a = bflo(c1[k]) * bflo(h1[k]), zz1b = bfhi(c1[k]) * bfhi(h1[k]);
                const float zz2a = bflo(c2[k]) * bflo(h2[k]), zz2b = bfhi(c2[k]) * bfhi(h2[k]);
                z0[2 * k] = zz0a; z0[2 * k + 1] = zz0b;
                y[2 * k] = bflo(bg[k]) * (w0[2 * k] * zz2a + w1[2 * k] * zz1a + w2[2 * k] * zz0a);
                y[2 * k + 1] = bfhi(bg[k]) * (w0[2 * k + 1] * zz2b + w1[2 * k + 1] * zz1b + w2[2 * k + 1] * zz0b);
            }
            u32x4 o; o.x = pk2(y[0], y[1]); o.y = pk2(y[2], y[3]); o.z = pk2(y[4], y[5]); o.w = pk2(y[6], y[7]);
            *(u32x4*)(a.YC + row * D + ch) = o;
            if (p >= SEQ - 2) { float* cs = a.out + OFF_CSP + ((size_t)n * 2 + (p - (SEQ - 2))) * 512 + ch;
                *(f32x4*)cs = (f32x4){z0[0], z0[1], z0[2], z0[3]}; *(f32x4*)(cs + 4) = (f32x4){z0[4], z0[5], z0[6], z0[7]}; }
        }
    }
    { const int s = tid >> 2, dq = tid & 3;
      const f32x4 q0 = *(const f32x4*)(a.VSS + (R0 + s) * 8), q1 = *(const f32x4*)(a.VSS + (R0 + s) * 8 + 4);
      const float r = 1.0f / sqrtf((((q0[0] + q0[1]) + (q0[2] + q0[3])) + ((q1[0] + q1[1]) + (q1[2] + q1[3]))) * (1.0f / 512.0f) + RMS_EPS);
#pragma unroll
      for (int i = 0; i < 4; ++i) { const int d = dq * 32 + i * 8; const u32x4 v = *(const u32x4*)(a.H0 + (R0 + s) * N_IN0 + 2048 + hd * 128 + d);
          const f32x4 n0 = *(const f32x4*)(a.norm_v + hd * 128 + d), n1 = *(const f32x4*)(a.norm_v + hd * 128 + d + 4);
          u32x4 o; o.x = pk2(gelu_t(bflo(v[0])) * r * n0[0], gelu_t(bfhi(v[0])) * r * n0[1]); o.y = pk2(gelu_t(bflo(v[1])) * r * n0[2], gelu_t(bfhi(v[1])) * r * n0[3]);
          o.z = pk2(gelu_t(bflo(v[2])) * r * n1[0], gelu_t(bfhi(v[2])) * r * n1[1]); o.w = pk2(gelu_t(bflo(v[3])) * r * n1[2], gelu_t(bfhi(v[3])) * r * n1[3]);
          *(LAS u32x4*)(lds + P2_VN + s * P2_PITCH + d * 2) = o; }
      const int t = s;
#pragma unroll
      for (int i = 0; i < 4; ++i) { const int s0 = dq * 32 + i * 8; const float* wp = a.w_spatial + ((size_t)hd * 128 + t) * 128 + s0;
          const f32x4 x0 = *(const f32x4*)wp, x1 = *(const f32x4*)(wp + 4);
          float x[8] = {x0[0], x0[1], x0[2], x0[3], x1[0], x1[1], x1[2], x1[3]};
#pragma unroll
          for (int k = 0; k < 8; ++k) if (s0 + k > t) x[k] = 0.f;
          u32x4 o; o.x = pk2(x[0], x[1]); o.y = pk2(x[2], x[3]); o.z = pk2(x[4], x[5]); o.w = pk2(x[6], x[7]);
          *(LAS u32x4*)(lds + P2_WT + t * P2_PITCH + s0 * 2) = o; }
    }
    __syncthreads();
    {
        const int tt = w & 3, dh = w >> 2, i = lane & 31, hh = lane >> 5;
        f32x16 acc0, acc1;
#pragma unroll
        for (int r = 0; r < 16; ++r) { acc0[r] = 0.f; acc1[r] = 0.f; }
        const int nks = 2 * (tt + 1);
        const LAS unsigned char* ap = lds + P2_WT + (32 * tt + i) * P2_PITCH + 16 * hh;
        const LAS unsigned char* vp = lds + P2_VN + (8 * hh + ((lane & 15) >> 2)) * P2_PITCH + (64 * dh + 16 * ((lane >> 4) & 1)) * 2 + 8 * (lane & 3);
        for (int ks = 0; ks < nks; ++ks) {
            const bf16x8 af = *(const LAS bf16x8*)(ap + ks * 32);
            const LAS unsigned char* v0 = vp + ks * 16 * P2_PITCH;
            const bf16x8 b0 = cat8(tr16(v0), tr16(v0 + 4 * P2_PITCH));
            const bf16x8 b1 = cat8(tr16(v0 + 64), tr16(v0 + 64 + 4 * P2_PITCH));
            acc0 = MFMA32(af, b0, acc0); acc1 = MFMA32(af, b1, acc1);
        }
#pragma unroll
        for (int r = 0; r < 16; ++r) { LAS bf16* mp = (LAS bf16*)(lds + P2_MX + (32 * tt + crow(r, hh)) * P2_PITCH) + 64 * dh + i;
            mp[0] = (bf16)(pk2(acc0[r], 0.f) & 0xffffu); mp[32] = (bf16)(pk2(acc1[r], 0.f) & 0xffffu); }
    }
    __syncthreads();
    { const int t = tid >> 2, dq = tid & 3; const size_t row = R0 + t; const float bs = a.b_spatial[hd * 128 + t];
#pragma unroll
      for (int i = 0; i < 4; ++i) { const int d = dq * 32 + i * 8;
          const u32x4 uu = *(const u32x4*)(a.H0 + row * N_IN0 + 1536 + hd * 128 + d); const u32x4 mx = *(const LAS u32x4*)(lds + P2_MX + t * P2_PITCH + d * 2);
          u32x4 o;
#pragma unroll
          for (int k = 0; k < 4; ++k) o[k] = pk2(gelu_t(bflo(uu[k])) * (bflo(mx[k]) + bs), gelu_t(bfhi(uu[k])) * (bfhi(mx[k]) + bs));
          *(u32x4*)(a.YC + row * D + 512 + hd * 128 + d) = o; } }
    __syncthreads();
}
__device__ __forceinline__ void p2_sample_row(const P2Args& a, int b, int lane) {
    const size_t row = (size_t)NP + b; const int ch = lane * 8; const bf16* hr = a.H0 + row * N_IN0;
    const u32x4 bg = *(const u32x4*)(hr + ch), cg = *(const u32x4*)(hr + 512 + ch), hc = *(const u32x4*)(hr + 1024 + ch), uu = *(const u32x4*)(hr + 1536 + ch), vv = *(const u32x4*)(hr + 2048 + ch);
    float bgf[8], z0[8], uf[8], gv[8];
#pragma unroll
    for (int k = 0; k < 4; ++k) { bgf[2 * k] = bflo(bg[k]); bgf[2 * k + 1] = bfhi(bg[k]); z0[2 * k] = bflo(cg[k]) * bflo(hc[k]); z0[2 * k + 1] = bfhi(cg[k]) * bfhi(hc[k]);
        uf[2 * k] = bflo(uu[k]); uf[2 * k + 1] = bfhi(uu[k]); gv[2 * k] = gelu_t(bflo(vv[k])); gv[2 * k + 1] = gelu_t(bfhi(vv[k])); }
    float s = 0.f;
#pragma unroll
    for (int k = 0; k < 8; ++k) s += gv[k] * gv[k];
    s = wave_sum(s); const float r = 1.0f / sqrtf(s * (1.0f / 512.0f) + RMS_EPS);
    const float* h0p = a.state_conv + ((size_t)b * 2 + 0) * 512 + ch; const float* h1p = a.state_conv + ((size_t)b * 2 + 1) * 512 + ch;
    const int hd = ch >> 7; const float w00 = a.w_spatial[(size_t)hd * 128 * 128], b0 = a.b_spatial[hd * 128];
    float yc[8], ym[8], vn[8], h1v[8];
#pragma unroll
    for (int k = 0; k < 8; ++k) { const float hist0 = h0p[k], hist1 = h1p[k]; h1v[k] = hist1;
        yc[k] = bgf[k] * (a.conv_w[ch + k] * hist0 + a.conv_w[512 + ch + k] * hist1 + a.conv_w[1024 + ch + k] * z0[k]);
        vn[k] = gv[k] * r * a.norm_v[ch + k]; ym[k] = gelu_t(uf[k]) * (w00 * vn[k] + b0); }
    u32x4 o; o.x = pk2(yc[0], yc[1]); o.y = pk2(yc[2], yc[3]); o.z = pk2(yc[4], yc[5]); o.w = pk2(yc[6], yc[7]);
    *(u32x4*)(a.YC + row * D + ch) = o;
    o.x = pk2(ym[0], ym[1]); o.y = pk2(ym[2], ym[3]); o.z = pk2(ym[4], ym[5]); o.w = pk2(ym[6], ym[7]);
    *(u32x4*)(a.YC + row * D + 512 + ch) = o;
    float* cs = a.out + OFF_CSS + (size_t)b * 1024 + ch;
    *(f32x4*)cs = (f32x4){h1v[0], h1v[1], h1v[2], h1v[3]}; *(f32x4*)(cs + 4) = (f32x4){h1v[4], h1v[5], h1v[6], h1v[7]};
    *(f32x4*)(cs + 512) = (f32x4){z0[0], z0[1], z0[2], z0[3]}; *(f32x4*)(cs + 516) = (f32x4){z0[4], z0[5], z0[6], z0[7]};
    float* cv = a.out + OFF_CVS + (size_t)b * 512 + ch;
    *(f32x4*)cv = (f32x4){vn[0], vn[1], vn[2], vn[3]}; *(f32x4*)(cv + 4) = (f32x4){vn[4], vn[5], vn[6], vn[7]};
}

__device__ __forceinline__ u32x2 pk4(f32x4 v, float s) { u32x2 o; o.x = pk2(v[0] * s, v[1] * s); o.y = pk2(v[2] * s, v[3] * s); return o; }

constexpr int CP_PITCH = 272, CP_TYPE = 32 * CP_PITCH, CP_BUF = 2 * CP_TYPE;
struct CmpArgs { const float* cache_kv; const int* page_table; const bf16* WCMP; float* PQ; unsigned* flags; };
__device__ __forceinline__ void cmp_sample_unit(const CmpArgs& a, int b, int half, LAS unsigned char* lds, int tid) {
    asm volatile("" : "+v"(tid));
    const int lane = tid & 63, w = __builtin_amdgcn_readfirstlane(tid >> 6), type = w >> 2, ntile = w & 3, i = lane & 31, hh = lane >> 5;
    const int row16 = tid >> 5, seg = row16 >> 1, lx = row16 & 1, chunk = tid & 31;
    int phys[8];
#pragma unroll
    for (int p = 0; p < 8; ++p) phys[p] = __builtin_amdgcn_readfirstlane(a.page_table[b * 16 + half * 8 + p]);
    const float* gsrc0 = a.cache_kv + (size_t)(seg * 16 + lx) * 1024 + chunk * 4;
    LAS unsigned char* sdst = lds + ((chunk >> 4) * 8 + seg) * CP_PITCH + (lx * 64 + (chunk & 15) * 4) * 2;
    const LAS unsigned char* ard = lds + type * CP_TYPE + i * CP_PITCH + 16 * hh;
    const bf16* brd = a.WCMP + (size_t)(type * 128 + ntile * 32 + i) * 1024 + 8 * hh;
    f32x16 acc[4];
    f32x4 rs[2][4];
#define CP_LOAD(SET, E, PH) do { const float* g_ = gsrc0 + ((size_t)(PH) * 128 + 2 * (E)) * 1024; _Pragma("unroll") for (int q_ = 0; q_ < 4; ++q_) rs[SET][q_] = *(const f32x4*)(g_ + 128 * q_); } while (0)
#define CP_STORE(SET, BUF) do { _Pragma("unroll") for (int q_ = 0; q_ < 4; ++q_) { u32x2 o_; o_.x = pk2(rs[SET][q_][0], rs[SET][q_][1]); o_.y = pk2(rs[SET][q_][2], rs[SET][q_][3]); \
        *(LAS u32x2*)(sdst + (BUF) * CP_BUF + (q_ >> 1) * CP_TYPE + (q_ & 1) * 16 * CP_PITCH) = o_; } } while (0)
    CP_LOAD(0, 0, phys[0]); CP_STORE(0, 0); CP_LOAD(1, 0, phys[1]); CP_LOAD(0, 0, phys[2]);
    asm volatile("s_waitcnt lgkmcnt(0)" ::: "memory"); __builtin_amdgcn_s_barrier(); asm volatile("" ::: "memory");
    bf16x8 bfr[8];
#pragma unroll
    for (int ks = 0; ks < 8; ++ks) bfr[ks] = *(const bf16x8*)(brd + ks * 16);
#pragma unroll 1
    for (int ep = 0; ep < 16; ++ep) { const int e = ep & 7, pass = ep >> 3;
        if (e == 0) {
#pragma unroll
            for (int p = 0; p < 4; ++p)
#pragma unroll
                for (int r = 0; r < 16; ++r) acc[p][r] = 0.f; }
#pragma unroll
        for (int p = 0; p < 4; ++p) {
#pragma unroll
            for (int kh = 0; kh < 2; ++kh) { bf16x8 af[4];
#pragma unroll
              for (int ks = 0; ks < 4; ++ks) af[ks] = *(const LAS bf16x8*)(ard + (p & 1) * CP_BUF + (4 * kh + ks) * 32);
#pragma unroll
              for (int ks = 0; ks < 4; ++ks) acc[p] = MFMA32(af[ks], bfr[4 * kh + ks], acc[p]);
              __builtin_amdgcn_sched_barrier(0); }
            if (p == 3) { const int en = (ep + 1) & 7;
#pragma unroll
                for (int ks = 0; ks < 8; ++ks) bfr[ks] = *(const bf16x8*)(brd + en * 128 + ks * 16);
                __builtin_amdgcn_sched_barrier(0); }
            if (p < 3 || ep < 15) CP_STORE((p + 1) & 1, (p + 1) & 1);
            { const int p5 = (p + 3) & 3, ep5 = ep + ((p + 3) >> 2);
              { const int ec = ep5 < 16 ? ep5 : 15;
                int pa_ = phys[p5], pb_ = phys[4 + p5]; asm volatile("" : "+s"(pa_), "+s"(pb_));
                const int ph = (ec >> 3) ? pb_ : pa_; CP_LOAD((p + 1) & 1, ec & 7, ph); } }
            asm volatile("s_waitcnt lgkmcnt(0)" ::: "memory"); __builtin_amdgcn_s_barrier(); asm volatile("" ::: "memory");
        }
        if (e == 7) {
#pragma unroll
            for (int p = 0; p < 4; ++p)
#pragma unroll
                for (int r = 0; r < 16; ++r) { const int ri = crow(r, hh), g = ri >> 3, sg = ri & 7;
                    a.PQ[((size_t)((type * NSMP + b) * 4 + g) * 128 + (half * 8 + pass * 4 + p) * 8 + sg) * 256 + type * 128 + ntile * 32 + i] = acc[p][r]; } }
    }
#undef CP_LOAD
#undef CP_STORE
    asm volatile("s_waitcnt vmcnt(0) lgkmcnt(0)" ::: "memory"); __syncthreads();
    if (tid == 0) { __builtin_amdgcn_fence(__ATOMIC_RELEASE, "agent"); asm volatile("s_waitcnt vmcnt(0)" ::: "memory");
        (void)__hip_atomic_fetch_add(a.flags + 64 * b, 1u, __ATOMIC_RELAXED, __HIP_MEMORY_SCOPE_AGENT); }
}

__device__ __forceinline__ void cmp_prompt_unit(const bf16* __restrict__ KVB, const bf16* __restrict__ WCMP, float* __restrict__ PQ, int u, LAS unsigned char* lds, int tid) {
    asm volatile("" : "+v"(tid));
    const int lane = tid & 63, w = __builtin_amdgcn_readfirstlane(tid >> 6), i = lane & 31, hh = lane >> 5, ty = u >> 7;
    const bf16* ap = KVB + (size_t)(32 * u + i) * 1024 + 128 * w + 8 * hh;
    const bf16* bp = WCMP + (size_t)(128 * ty + i) * 1024 + 128 * w + 8 * hh;
    f32x16 acc[4];
#pragma unroll
    for (int ct = 0; ct < 4; ++ct)
#pragma unroll
        for (int r = 0; r < 16; ++r) acc[ct][r] = 0.f;
#pragma unroll 1
    for (int s0 = 0; s0 < 8; s0 += 4) { bf16x8 af[4], bf[4][4];
#pragma unroll
        for (int s = 0; s < 4; ++s) { af[s] = *(const bf16x8*)(ap + 16 * (s0 + s));
#pragma unroll
            for (int ct = 0; ct < 4; ++ct) bf[s][ct] = *(const bf16x8*)(bp + (size_t)32 * ct * 1024 + 16 * (s0 + s)); }
        __builtin_amdgcn_sched_barrier(0);
#pragma unroll
        for (int s = 0; s < 4; ++s)
#pragma unroll
            for (int ct = 0; ct < 4; ++ct) acc[ct] = MFMA32(af[s], bf[s][ct], acc[ct]);
        __builtin_amdgcn_sched_barrier(0); }
    LAS float* red = (LAS float*)lds;
#pragma unroll
    for (int ct = 0; ct < 4; ++ct)
#pragma unroll
        for (int r4 = 0; r4 < 4; ++r4) *(LAS f32x4*)(red + ((((w * 4 + ct) * 4 + r4) * 64) + lane) * 4) = (f32x4){acc[ct][4 * r4], acc[ct][4 * r4 + 1], acc[ct][4 * r4 + 2], acc[ct][4 * r4 + 3]};
    __syncthreads();
#pragma unroll
    for (int bb = 0; bb < 2; ++bb) { const int blk = 2 * w + bb, ct = blk >> 2, r4 = blk & 3;
        f32x4 sum = (f32x4){0.f, 0.f, 0.f, 0.f};
#pragma unroll
        for (int ws = 0; ws < 8; ++ws) sum = sum + *(const LAS f32x4*)(red + ((((ws * 4 + ct) * 4 + r4) * 64) + lane) * 4);
        float* op = PQ + ((size_t)CMP_ROWS_S + 32 * u + 8 * r4 + 4 * hh) * 256 + 128 * ty + 32 * ct + i;
#pragma unroll
        for (int j = 0; j < 4; ++j) op[(size_t)j * 256] = sum[j]; }
    __syncthreads();
}

constexpr int AP = 144;
constexpr int A_CK = 0, A_CV = 32768, A_RING = 65536, A_SLOT = 16384, A_NSLOT = 3, A_IMP = A_RING + A_NSLOT * A_SLOT, A_ROWF = A_IMP + 8 * 8 * 64 * 4, A_MSK = A_ROWF + 8 * 32 * 4, A_END = A_MSK + 8 * 8 * 8;
static_assert(A_END <= LDSCTL_OFF, "attention LDS map");
struct AttnArgs { const bf16 *Q, *QR, *KVB; const float *PQ, *CB, *G; bf16* O; };

__device__ __forceinline__ void row_factors(LAS float* rowf, float f, int q, int hh, float (&fr)[16]) {
    if (hh == 0) rowf[q] = f;
#pragma unroll
    for (int r = 0; r < 16; ++r) fr[r] = rowf[crow(r, hh)];
}

template <int MODE>
__device__ __forceinline__ void flash_branch(const bf16* __restrict__ Kg, const bf16* __restrict__ Vg, int tile_lo, int tile_hi, const bf16x8 (&qf)[4], int t, unsigned long long mlane,
                                             f32x16& o0, f32x16& o1, float& l_out, LAS unsigned char* lds, LAS float* rowf, int tid, int lane) {
    asm volatile("" : "+v"(tid), "+v"(lane));
    const int i = lane & 31, hh = lane >> 5; const int w = __builtin_amdgcn_readfirstlane(tid >> 6);
    const bf16* ksrc = Kg + (size_t)lane * 64 + 8 * w;
    const bf16* vsrc = Vg + (size_t)(16 * (w & 3) + (lane >> 2)) * 64 + 32 * (w >> 2) + 8 * (lane & 3);
    LAS unsigned char* ring = lds + A_RING + w * 1024;
#define FB_ISSUE(T, S) do { __builtin_amdgcn_global_load_lds((const unsigned*)(ksrc + (size_t)(T) * 4096), (LAS unsigned*)(ring + (S) * A_SLOT), 16, 0, 0); \
                            __builtin_amdgcn_global_load_lds((const unsigned*)(vsrc + (size_t)(T) * 4096), (LAS unsigned*)(ring + (S) * A_SLOT + 8192), 16, 0, 0); } while (0)
    float l = 0.f; bool seen = false;
    f32x16 negm;
#pragma unroll
    for (int r = 0; r < 16; ++r) { o0[r] = 0.f; o1[r] = 0.f; negm[r] = 0.f; }
    asm volatile("s_waitcnt vmcnt(0)" ::: "memory");
    FB_ISSUE(tile_lo, 0); if (tile_lo < tile_hi) FB_ISSUE(tile_lo + 1, 1);
    int sc = 0, sn = 2;
    const LAS unsigned char* kbase = lds + A_RING + kappa(i) * 16 + hh * 1024;
    const LAS unsigned char* vbase = lds + A_RING + 8192 + hh * 1024 + ((lane & 15) >> 2) * 64 + ((lane >> 4) & 1) * 32 + (lane & 3) * 8;
    for (int tile = tile_lo; tile <= tile_hi; ++tile) {
        if (tile < tile_hi) asm volatile("s_waitcnt vmcnt(2)" ::: "memory"); else asm volatile("s_waitcnt vmcnt(0)" ::: "memory");
        __builtin_amdgcn_s_barrier(); asm volatile("" ::: "memory");
        if (tile + 2 <= tile_hi) FB_ISSUE(tile + 2, sn);
        const LAS unsigned char* kt = kbase + sc * A_SLOT; const LAS unsigned char* vt = vbase + sc * A_SLOT;
        sc = sc == 2 ? 0 : sc + 1; sn = sn == 2 ? 0 : sn + 1;
        const bool sel = MODE == 0 ? ((mlane >> tile) & 1ull) != 0ull : true;
        if (__any(sel)) {
            f32x16 s0, s1;
            if (MODE == 0) {
#pragma unroll
                for (int r = 0; r < 16; ++r) s0[r] = sel ? negm[r] : -1e30f;
            } else s0 = negm;
            s1 = s0;
            { bf16x8 kf[8];
#pragma unroll
              for (int st = 0; st < 4; ++st) { kf[2 * st] = *(const LAS bf16x8*)(kt + st * 2048); kf[2 * st + 1] = *(const LAS bf16x8*)(kt + st * 2048 + 512); }
              __builtin_amdgcn_sched_barrier(0);
#pragma unroll
              for (int st = 0; st < 4; ++st) { s0 = MFMA32(kf[2 * st], qf[st], s0); s1 = MFMA32(kf[2 * st + 1], qf[st], s1); } }
            s16x4 vr0[8];
#pragma unroll
            for (int s2 = 0; s2 < 2; ++s2) { const LAS unsigned char* v0 = vt + 8 * s2 * 64;
                vr0[4 * s2] = tr16(v0); vr0[4 * s2 + 1] = tr16(v0 + 4 * 64); vr0[4 * s2 + 2] = tr16(v0 + 4096); vr0[4 * s2 + 3] = tr16(v0 + 4096 + 4 * 64); }
            __builtin_amdgcn_sched_barrier(0);
            const bool bnd = (tile == tile_hi) || (MODE == 1 && tile + 8 == tile_hi);
            if (bnd) {
                const int kb = 64 * tile + 16 * hh;
#pragma unroll
                for (int r = 0; r < 16; ++r) { const int k0 = kb + r, k1 = kb + 32 + r;
                    const bool v0 = MODE == 0 ? (k0 <= t) : (k0 <= t && k0 + 512 > t), v1 = MODE == 0 ? (k1 <= t) : (k1 <= t && k1 + 512 > t);
                    s0[r] = v0 ? s0[r] : -1e30f; s1[r] = v1 ? s1[r] : -1e30f; }
            }
            const bool exact = __any(sel && !seen);
            if (exact) {
                asm volatile("s_nop 15\n\ts_nop 7" : "+v"(s0), "+v"(s1));
                float tm = max3f(s0[0], s1[0], s0[1]), tm2 = max3f(s1[1], s0[2], s1[2]);
#pragma unroll
                for (int r = 3; r < 15; r += 2) { tm = max3f(tm, s0[r], s1[r]); tm2 = max3f(tm2, s0[r + 1], s1[r + 1]); }
                tm = max3f(tm, s0[15], s1[15]); tm = xhalf_max(fmaxf(tm, tm2));
                const bool first = !seen && tm > -1e29f; const bool resc = first || (seen && tm > 8.0f);
                if (__any(resc)) {
                    const float delta = resc ? tm : 0.f; const float alpha = (resc && !first) ? __builtin_amdgcn_exp2f(-delta) : 1.0f; l *= alpha; seen = seen || first;
#pragma unroll
                    for (int r = 0; r < 16; ++r) { negm[r] -= delta; s0[r] -= delta; s1[r] -= delta; }
                    float fr[16]; row_factors(rowf, alpha, i, hh, fr);
#pragma unroll
                    for (int r = 0; r < 16; ++r) { o0[r] *= fr[r]; o1[r] *= fr[r]; }
                }
            }
            f32x2_t la = {0.f, 0.f}, lb = {0.f, 0.f};
#pragma unroll
            for (int r = 0; r < 16; r += 2) { s0[r] = __builtin_amdgcn_exp2f(s0[r]); s0[r + 1] = __builtin_amdgcn_exp2f(s0[r + 1]); s1[r] = __builtin_amdgcn_exp2f(s1[r]); s1[r + 1] = __builtin_amdgcn_exp2f(s1[r + 1]);
                la += (f32x2_t){s0[r], s0[r + 1]}; lb += (f32x2_t){s1[r], s1[r + 1]}; }
            la += lb; const float ls = la[0] + la[1];
            l += ls;
            { bf16x8 pa[2]; s16x4 vr1[8];
#pragma unroll
              for (int s2 = 0; s2 < 2; ++s2) { u32x4 pw;
#pragma unroll
                  for (int k = 0; k < 4; ++k) pw[k] = pk2(s0[8 * s2 + 2 * k], s0[8 * s2 + 2 * k + 1]);
                  pa[s2] = __builtin_bit_cast(bf16x8, pw); }
#pragma unroll
              for (int s2 = 0; s2 < 2; ++s2) { const LAS unsigned char* v0 = vt + 2 * 1024 + 8 * s2 * 64;
                  vr1[4 * s2] = tr16(v0); vr1[4 * s2 + 1] = tr16(v0 + 4 * 64); vr1[4 * s2 + 2] = tr16(v0 + 4096); vr1[4 * s2 + 3] = tr16(v0 + 4096 + 4 * 64); }
              __builtin_amdgcn_sched_barrier(0);
#pragma unroll
              for (int s2 = 0; s2 < 2; ++s2) { o0 = MFMA32(pa[s2], cat8(vr0[4 * s2], vr0[4 * s2 + 1]), o0); o1 = MFMA32(pa[s2], cat8(vr0[4 * s2 + 2], vr0[4 * s2 + 3]), o1); }
#pragma unroll
              for (int s2 = 0; s2 < 2; ++s2) { u32x4 pw;
#pragma unroll
                  for (int k = 0; k < 4; ++k) pw[k] = pk2(s1[8 * s2 + 2 * k], s1[8 * s2 + 2 * k + 1]);
                  pa[s2] = __builtin_bit_cast(bf16x8, pw); }
              __builtin_amdgcn_sched_barrier(0);
#pragma unroll
              for (int s2 = 0; s2 < 2; ++s2) { o0 = MFMA32(pa[s2], cat8(vr1[4 * s2], vr1[4 * s2 + 1]), o0); o1 = MFMA32(pa[s2], cat8(vr1[4 * s2 + 2], vr1[4 * s2 + 3]), o1); } }
            if (!exact && __any(ls > 4096.0f)) {
                const float lm = xhalf_max(ls); const bool big = lm > 4096.0f;
                const int e = big ? __builtin_amdgcn_frexp_expf(lm) : 0; const float alpha = __builtin_amdgcn_ldexpf(1.0f, -e), delta = (float)e;
                l *= alpha;
#pragma unroll
                for (int r = 0; r < 16; ++r) negm[r] -= delta;
                float fr[16]; row_factors(rowf, alpha, i, hh, fr);
#pragma unroll
                for (int r = 0; r < 16; ++r) { o0[r] *= fr[r]; o1[r] *= fr[r]; }
            }
        }
        asm volatile("s_waitcnt lgkmcnt(0)" ::: "memory");
    }
    __builtin_amdgcn_s_barrier(); asm volatile("" ::: "memory");
#undef FB_ISSUE
    l_out = xhalf_sum(l);
}

__device__ __forceinline__ void attn_build_ckcv(const AttnArgs& a, int ng, LAS unsigned char* lds, int tid) {
    asm volatile("" : "+v"(tid));
    const int c = tid >> 1, e0 = (tid & 1) * 32; const int cc = c < 255 ? c : 254; const float keep = c < 255 ? 1.0f : 0.0f;
    const float* pk = a.PQ + ((size_t)CMP_ROWS_S + (size_t)ng * 256 + cc) * 256 + e0; const float* pv = a.PQ + ((size_t)CMP_ROWS_S + (size_t)(16 + ng) * 256 + cc) * 256 + e0;
    const float* cb = a.CB + e0;
    LAS unsigned char* dk = lds + A_CK + (e0 >> 3) * 4096 + c * 16; LAS unsigned char* dv = lds + A_CV + ((e0 >> 5) * 16 + (c >> 4)) * 1024 + (c & 15) * 64;
#pragma unroll 2
    for (int k = 0; k < 8; ++k) { const int e = 4 * k;
        const f32x4 kv = (*(const f32x4*)(pk + e) + *(const f32x4*)(pk + 256 + 64 + e) + *(const f32x4*)(cb + e)) * keep;
        const f32x4 vv = (*(const f32x4*)(pv + 128 + e) + *(const f32x4*)(pv + 256 + 192 + e) + *(const f32x4*)(cb + 64 + e)) * keep;
        *(LAS u32x2*)(dk + (e >> 3) * 4096 + (e & 7) * 2) = pk4(kv, 1.0f); *(LAS u32x2*)(dv + e * 2) = pk4(vv, 1.0f); }
    __syncthreads();
}

__device__ __forceinline__ void attn_prompt_unit(const AttnArgs& a, int n, int g, int qt, LAS unsigned char* lds, int tid) {
    asm volatile("" : "+v"(tid));
    const int lane = tid & 63, w = tid >> 6, i = lane & 31, hh = lane >> 5, tau = i >> 2, h = i & 3;
    const int tb = 64 * qt + 8 * w, t = tb + tau; const size_t row = (size_t)n * SEQ + t; const int ng = n * 4 + g;
    LAS float* rowf = (LAS float*)(lds + A_ROWF) + w * 32;
    LAS float* impb = (LAS float*)(lds + A_IMP) + w * 512;
    bf16x8 qf[4];
#pragma unroll
    for (int st = 0; st < 4; ++st) qf[st] = *(const bf16x8*)(a.Q + row * D + (4 * g + h) * 64 + 16 * st + 8 * hh);
    const float g0 = a.G[row * 48 + g * 12 + h * 3 + 0], g1 = a.G[row * 48 + g * 12 + h * 3 + 1], g2 = a.G[row * 48 + g * 12 + h * 3 + 2];
    __syncthreads();
    f32x16 oa0, oa1;
    unsigned long long mlane = 0ull;
    {
        const LAS unsigned char* kp = lds + A_CK + hh * 4096 + kappa(i) * 16;
        const int cmax = t >= 31 ? ((t - 31) >> 4) : -1;
        const int cw = __builtin_amdgcn_readfirstlane((tb + 7) >= 31 ? ((tb + 7 - 31) >> 4) : -1);
        float mref = 0.f, sum = 0.f, prevo = 0.f; bool seen = false; float wsum[8][4];
        f32x16 oc0, oc1;
#pragma unroll
        for (int r = 0; r < 16; ++r) { oc0[r] = 0.f; oc1[r] = 0.f; }
        const LAS unsigned char* vp = lds + A_CV + hh * 1024 + ((lane & 15) >> 2) * 64 + 32 * ((lane >> 4) & 1) + 8 * (lane & 3);
#pragma unroll
        for (int T = 0; T < 8; ++T) if (32 * T > cw) {
#pragma unroll
            for (int jl = 0; jl < 4; ++jl) wsum[T][jl] = 0.f; }
          else { f32x16 acc;
#pragma unroll
            for (int r = 0; r < 16; ++r) acc[r] = -mref;
            { bf16x8 kf[4];
#pragma unroll
              for (int st = 0; st < 4; ++st) kf[st] = *(const LAS bf16x8*)(kp + T * 512 + st * 8192);
              __builtin_amdgcn_sched_barrier(0);
#pragma unroll
              for (int st = 0; st < 4; ++st) acc = MFMA32(kf[st], qf[st], acc); }
            const int kb = 32 * T + 16 * hh; float tm = -1e30f;
#pragma unroll
            for (int r = 0; r < 16; ++r) { acc[r] = (kb + r) <= cmax ? acc[r] : -1e30f; tm = fmaxf(tm, acc[r]); }
            tm = xhalf_max(tm);
            const bool first = !seen && tm > -1e29f; const bool resc = first || (seen && tm > 8.0f);
            if (__any(resc)) {
                const float delta = resc ? tm : 0.f; const float alpha = (resc && !first) ? __builtin_amdgcn_exp2f(-delta) : 1.0f; mref += delta; sum *= alpha; prevo *= alpha; seen = seen || first;
#pragma unroll
                for (int r = 0; r < 16; ++r) acc[r] -= delta;
#pragma unroll
                for (int T2 = 0; T2 < 8; ++T2) if (T2 < T) {
#pragma unroll
                    for (int jl = 0; jl < 4; ++jl) wsum[T2][jl] *= alpha; }
                float fr[16]; row_factors(rowf, alpha, i, hh, fr);
#pragma unroll
                for (int r = 0; r < 16; ++r) { oc0[r] *= fr[r]; oc1[r] *= fr[r]; }
            }
#pragma unroll
            for (int r = 0; r < 16; ++r) { acc[r] = __builtin_amdgcn_exp2f(acc[r]); sum += acc[r]; }
            const float o15 = xhalf_other(acc[15], hh); const float left = hh ? o15 : prevo; prevo = o15;
#pragma unroll
            for (int jl = 0; jl < 4; ++jl) wsum[T][jl] = (acc[4 * jl] + acc[4 * jl + 1]) + (acc[4 * jl + 2] + acc[4 * jl + 3]) + (jl == 0 ? left : acc[jl == 0 ? 0 : 4 * jl - 1]);
#pragma unroll
            for (int s2 = 0; s2 < 2; ++s2) { u32x4 pw;
#pragma unroll
                for (int k = 0; k < 4; ++k) pw[k] = pk2(acc[8 * s2 + 2 * k], acc[8 * s2 + 2 * k + 1]);
                const bf16x8 pa = __builtin_bit_cast(bf16x8, pw);
                const LAS unsigned char* v0 = vp + T * 2048 + s2 * 512;
                oc0 = MFMA32(pa, cat8(tr16(v0), tr16(v0 + 256)), oc0);
                oc1 = MFMA32(pa, cat8(tr16(v0 + 16384), tr16(v0 + 16384 + 256)), oc1); }
            __builtin_amdgcn_sched_barrier(0);
        }
        sum = xhalf_sum(sum);
        const float inv = sum > 0.f ? 1.0f / sum : 0.f;
#pragma unroll
        for (int T = 0; T < 8; ++T)
#pragma unroll
            for (int jl = 0; jl < 4; ++jl) { float ws = wsum[T][jl] * inv; ws += lane_xor<1>(ws); ws += lane_xor<2>(ws);
                if (h == 0) impb[tau * 64 + 8 * T + 4 * hh + jl] = ws; }
        float fr[16]; row_factors(rowf, g0 * inv, i, hh, fr);
#pragma unroll
        for (int r = 0; r < 16; ++r) { oa0[r] = oc0[r] * fr[r]; oa1[r] = oc1[r] * fr[r]; }
    }
    {
        LAS unsigned long long* maskb = (LAS unsigned long long*)(lds + A_MSK) + w * 8;
        const int tk8 = lane >> 3, sub = lane & 7; const int tt = tb + tk8, cur = tt >> 6;
        const f32x4 i0 = *(const LAS f32x4*)(impb + tk8 * 64 + 8 * sub), i1 = *(const LAS f32x4*)(impb + tk8 * 64 + 8 * sub + 4);
        unsigned key[8];
#pragma unroll
        for (int e = 0; e < 8; ++e) { const int j = 8 * sub + e; const float imp = e < 4 ? i0[e & 3] : i1[e & 3];
            const bool valid = j <= cur, forced = (j == 0) || (j == cur) || (j == cur - 1);
            key[e] = valid ? __float_as_uint(imp + (forced ? 1e4f : 0.f)) : 0u; }
        unsigned thr = 0u;
#pragma unroll 1
        for (int bit = 30; bit >= 0; --bit) { const unsigned cand = thr | (1u << bit); int c = 0;
#pragma unroll
            for (int e = 0; e < 8; ++e) c += key[e] >= cand ? 1 : 0;
            float cf = (float)c; cf += dpp_mov<0xB1>(cf); cf += dpp_mov<0x4E>(cf); cf += dpp_mov<0x141>(cf);
            thr = cf >= 16.0f ? cand : thr; }
        unsigned bits = 0u; int c = 0;
#pragma unroll
        for (int e = 0; e < 8; ++e) { const bool s_ = key[e] >= thr; bits |= s_ ? (1u << e) : 0u; c += s_ ? 1 : 0; }
        float cf = (float)c; cf += dpp_mov<0xB1>(cf); cf += dpp_mov<0x4E>(cf); cf += dpp_mov<0x141>(cf);
        if (cur < 16) { bits = 0u;
#pragma unroll
            for (int e = 0; e < 8; ++e) bits |= (8 * sub + e) <= cur ? (1u << e) : 0u; }
        ((LAS unsigned char*)maskb)[tk8 * 8 + sub] = (unsigned char)bits;
        const bool ok = cur < 16 || cf == 16.0f;
        if (!__all(ok)) {
#pragma unroll 1
            for (int tk = 0; tk < 8; ++tk) {
                const int tt2 = tb + tk, cur2 = tt2 >> 6;
                unsigned long long sel;
                if (cur2 < 16) sel = (2ull << cur2) - 1ull;
                else {
                    const float imp = impb[tk * 64 + lane];
                    const bool valid = lane <= cur2, forced = (lane == 0) || (lane == cur2) || (lane == cur2 - 1);
                    const unsigned key1 = valid ? __float_as_uint(imp + (forced ? 1e4f : 0.f)) : 0u;
                    unsigned thr1 = 0u;
#pragma unroll 1
                    for (int bit = 30; bit >= 0; --bit) { const unsigned cand = thr1 | (1u << bit); if (__popcll(__ballot(key1 >= cand)) >= 16) thr1 = cand; }
                    const unsigned long long gt = __ballot(key1 > thr1); unsigned long long eq = __ballot(key1 == thr1);
                    int need = 16 - __popcll(gt); sel = gt;
                    while (need > 0 && eq) { const unsigned long long low = eq & (0ull - eq); sel |= low; eq ^= low; --need; }
                }
                if (lane == 0) maskb[tk] = sel;
            }
        }
        mlane = maskb[tau];
    }
    { int tq = t, hq = h, hhq = hh; asm volatile("" : "+v"(tq), "+v"(hq), "+v"(hhq));
      const bf16* qp = a.QR + ((size_t)n * SEQ + tq) * D + (4 * g + hq) * 64 + 8 * hhq;
#pragma unroll
      for (int st = 0; st < 4; ++st) qf[st] = *(const bf16x8*)(qp + 16 * st); }
    {
        f32x16 o0, o1; float l;
        flash_branch<0>(a.KVB + 2 * KVB_TY + (size_t)ng * SEQ * 64, a.KVB + 3 * KVB_TY + (size_t)ng * SEQ * 64, 0, qt, qf, t, mlane, o0, o1, l, lds, rowf, tid, lane);
        float fr[16]; row_factors(rowf, l > 0.f ? g1 / l : 0.f, i, hh, fr);
#pragma unroll
        for (int r = 0; r < 16; ++r) { oa0[r] += o0[r] * fr[r]; oa1[r] += o1[r] * fr[r]; }
    }
    {
        f32x16 o0, o1; float l;
        flash_branch<1>(a.KVB + 4 * KVB_TY + (size_t)ng * SEQ * 64, a.KVB + 5 * KVB_TY + (size_t)ng * SEQ * 64, qt >= 8 ? qt - 8 : 0, qt, qf, t, 0ull, o0, o1, l, lds, rowf, tid, lane);
        float fr[16]; row_factors(rowf, l > 0.f ? g2 / l : 0.f, i, hh, fr);
#pragma unroll
        for (int r = 0; r < 16; ++r) { oa0[r] += o0[r] * fr[r]; oa1[r] += o1[r] * fr[r]; }
    }
    { int io = i, ho = hh; asm volatile("" : "+v"(io), "+v"(ho));
      bf16* ob = a.O + ((size_t)n * SEQ + tb) * D + 4 * g * 64 + io;
#pragma unroll
      for (int r = 0; r < 16; ++r) { const int q4 = (r & 3) + 8 * (r >> 2);
          bf16* op = ob + (size_t)((q4 >> 2) + ho) * D + (q4 & 3) * 64;
          op[0] = (bf16)(pk2(oa0[r], 0.f) & 0xffffu); op[32] = (bf16)(pk2(oa1[r], 0.f) & 0xffffu); } }
    __syncthreads();
}

constexpr int S_BASE = 133632;
constexpr int S_SC = S_BASE, S_QN = S_BASE + 2048, S_QR = S_BASE + 3072, S_IMP = S_BASE + 4096, S_MASK = S_BASE + 4352, S_PM = S_BASE + 4608, S_PL = S_BASE + 4736, S_PO = S_BASE + 4864, S_END = S_PO + 8 * 4 * 64 * 4;
static_assert(S_BASE >= MISC_OFF + 128 && S_END <= LDS_BYTES, "sample LDS map");
struct SmpArgs { const bf16 *Q, *QR; const float *PQ, *CB, *G, *cache_kv, *cache_win; const int* page_table; const float* out; bf16* O; unsigned* flags; };
__device__ __forceinline__ int nth_bit(unsigned long long m, int n) { for (int x = 0; x < n; ++x) m &= m - 1ull; return __builtin_ctzll(m); }
__device__ __forceinline__ float dot4(f32x4 a, f32x4 b) { return (a[0] * b[0] + a[1] * b[1]) + (a[2] * b[2] + a[3] * b[3]); }
__device__ __forceinline__ float grp16_sum(float v) { return sum16(v); }
__device__ __forceinline__ void smp_update(const f32x4 kx, const f32x4 vx, const bool valid, const f32x4 (&qv)[4], float (&m)[4], float (&l)[4], f32x4 (&o)[4]) {
#pragma unroll
    for (int h = 0; h < 4; ++h) { const float s = grp16_sum(dot4(kx, qv[h]));
        const float mn = valid ? fmaxf(m[h], s) : m[h]; const float al = __builtin_amdgcn_exp2f(m[h] - mn); const float p = valid ? __builtin_amdgcn_exp2f(s - mn) : 0.f;
        l[h] = l[h] * al + p; o[h] = o[h] * al + vx * p; m[h] = mn; }
}
__device__ __forceinline__ void smp_batch(const f32x4 (&kx)[8], const f32x4 (&vx)[8], const f32x4 (&qv)[4], float (&m)[4], float (&l)[4], f32x4 (&o)[4]) {
#pragma unroll
    for (int h = 0; h < 4; ++h) { float s[8];
#pragma unroll
        for (int u = 0; u < 8; ++u) s[u] = grp16_sum(dot4(kx[u], qv[h]));
        const float bm = fmaxf(max3f(max3f(s[0], s[1], s[2]), max3f(s[3], s[4], s[5]), s[6]), s[7]);
        const bool mv = bm > m[h] + 8.0f;
        if (__any(mv)) { const float mn = mv ? bm : m[h]; const float al = __builtin_amdgcn_exp2f(m[h] - mn); l[h] *= al; o[h] = o[h] * al; m[h] = mn; }
#pragma unroll
        for (int u = 0; u < 8; ++u) { const float p = __builtin_amdgcn_exp2f(s[u] - m[h]); l[h] += p; o[h] = o[h] + vx[u] * p; } }
}
__device__ __forceinline__ float smp_merge(float (&m)[4], float (&l)[4], f32x4 (&o)[4], LAS unsigned char* lds, int tid) {
    const int lane = tid & 63, w = tid >> 6, kq = lane >> 4, d4 = lane & 15, hh = lane >> 5;
    LAS float* pm = (LAS float*)(lds + S_PM); LAS float* pl = (LAS float*)(lds + S_PL); LAS float* po = (LAS float*)(lds + S_PO);
#pragma unroll
    for (int h = 0; h < 4; ++h) {
        { const float m2 = lane_xor<16>(m[h]), l2 = lane_xor<16>(l[h]); f32x4 o2; o2[0] = lane_xor<16>(o[h][0]); o2[1] = lane_xor<16>(o[h][1]); o2[2] = lane_xor<16>(o[h][2]); o2[3] = lane_xor<16>(o[h][3]);
          const float mt = fmaxf(m[h], m2), a1 = __builtin_amdgcn_exp2f(m[h] - mt), a2 = __builtin_amdgcn_exp2f(m2 - mt); l[h] = l[h] * a1 + l2 * a2; o[h] = o[h] * a1 + o2 * a2; m[h] = mt; }
        { const float m2 = xhalf_other(m[h], hh), l2 = xhalf_other(l[h], hh); f32x4 o2; o2[0] = xhalf_other(o[h][0], hh); o2[1] = xhalf_other(o[h][1], hh); o2[2] = xhalf_other(o[h][2], hh); o2[3] = xhalf_other(o[h][3], hh);
          const float mt = fmaxf(m[h], m2), a1 = __builtin_amdgcn_exp2f(m[h] - mt), a2 = __builtin_amdgcn_exp2f(m2 - mt); l[h] = l[h] * a1 + l2 * a2; o[h] = o[h] * a1 + o2 * a2; m[h] = mt; }
        if (kq == 0) { *(LAS f32x4*)(po + (w * 4 + h) * 64 + 4 * d4) = o[h]; if (d4 == 0) { pm[w * 4 + h] = m[h]; pl[w * 4 + h] = l[h]; } }
    }
    __syncthreads();
    float res = 0.f;
    if (tid < 256) { const int h = tid >> 6, e = tid & 63; float mt = -1e30f;
#pragma unroll
        for (int ww = 0; ww < 8; ++ww) mt = fmaxf(mt, pm[ww * 4 + h]);
        float L = 0.f, O = 0.f;
#pragma unroll
        for (int ww = 0; ww < 8; ++ww) { const float sc = __builtin_amdgcn_exp2f(pm[ww * 4 + h] - mt); L += pl[ww * 4 + h] * sc; O += po[(ww * 4 + h) * 64 + e] * sc; }
        res = L > 0.f ? O / L : 0.f; }
    __syncthreads();
    return res;
}
__device__ __forceinline__ void attn_sample_item(const SmpArgs& a, int b, int g, LAS unsigned char* lds, int tid) {
    asm volatile("" : "+v"(tid));
    const int lane = tid & 63, w = tid >> 6, kq = lane >> 4, d4 = lane & 15; const size_t row = (size_t)NP + b;
    LAS float* sc = (LAS float*)(lds + S_SC); LAS float* qn = (LAS float*)(lds + S_QN); LAS float* qr = (LAS float*)(lds + S_QR);
    LAS unsigned long long* maskp = (LAS unsigned long long*)(lds + S_MASK);
    if (tid < 64) { unsigned sp = 0u;
        while ((unsigned)__builtin_amdgcn_readfirstlane((int)__hip_atomic_load(a.flags + 64 * b, __ATOMIC_RELAXED, __HIP_MEMORY_SCOPE_AGENT)) < 2u) { __builtin_amdgcn_s_sleep(2); if (++sp > (1u << 20)) break; }
        __builtin_amdgcn_fence(__ATOMIC_ACQUIRE, "agent"); asm volatile("s_waitcnt vmcnt(0)" ::: "memory"); }
    if (tid < 256) { const int hd = tid >> 6, d = tid & 63; qn[tid] = bf1(a.Q[row * D + (4 * g + hd) * 64 + d]); qr[tid] = bf1(a.QR[row * D + (4 * g + hd) * 64 + d]); }
    __syncthreads();
    f32x4 qv[4];
#pragma unroll
    for (int h = 0; h < 4; ++h) qv[h] = *(const LAS f32x4*)(qn + h * 64 + 4 * d4);
    const float* pqk = a.PQ + ((size_t)(b * 4 + g) * 128) * 256 + 4 * d4;
    const float* pqv = a.PQ + ((size_t)((NSMP + b) * 4 + g) * 128) * 256 + 4 * d4;
    { const f32x4 cbk = *(const f32x4*)(a.CB + 4 * d4);
#pragma unroll
      for (int it = 0; it < 4; ++it) { const int c = 16 * w + 4 * it + kq; const int cc = c < 127 ? c : 126;
          const f32x4 kx = *(const f32x4*)(pqk + (size_t)cc * 256) + *(const f32x4*)(pqk + (size_t)(cc + 1) * 256 + 64) + cbk;
#pragma unroll
          for (int h = 0; h < 4; ++h) { const float s = grp16_sum(dot4(kx, qv[h])); if (d4 == 0) sc[h * 128 + c] = c < 127 ? s : -1e30f; } } }
    __syncthreads();
    if (w < 4) { LAS float* r = sc + w * 128; const float v0 = r[lane], v1 = r[lane + 64]; const float mx = wave_max(fmaxf(v0, v1));
        const float p0 = v0 > -1e29f ? __builtin_amdgcn_exp2f(v0 - mx) : 0.f, p1 = v1 > -1e29f ? __builtin_amdgcn_exp2f(v1 - mx) : 0.f;
        const float s = wave_sum(p0 + p1); const float inv = s > 0.f ? 1.0f / s : 0.f; r[lane] = p0 * inv; r[lane + 64] = p1 * inv; }
    __syncthreads();
    if (tid < 64) { float s = 0.f;
        if (tid < 33) for (int nn = 4 * tid - 1; nn <= 4 * tid + 3; ++nn) if (nn >= 0 && nn < 127) s += (sc[nn] + sc[128 + nn]) + (sc[256 + nn] + sc[384 + nn]);
        const bool valid = tid < 33, forced = (tid == 0) || (tid == 32) || (tid == 31);
        const unsigned key = valid ? __float_as_uint(s + (forced ? 1e4f : 0.f)) : 0u;
        unsigned thr = 0u;
#pragma unroll 1
        for (int bit = 30; bit >= 0; --bit) { const unsigned cand = thr | (1u << bit); if (__popcll(__ballot(key >= cand)) >= 16) thr = cand; }
        const unsigned long long gt = __ballot(key > thr); unsigned long long eq = __ballot(key == thr);
        int need = 16 - __popcll(gt); unsigned long long sel = gt;
        while (need > 0 && eq) { const unsigned long long low = eq & (0ull - eq); sel |= low; eq ^= low; --need; }
        if (tid == 0) *maskp = sel; }
    float ocmp;
    { float m[4], l[4]; f32x4 o[4];
#pragma unroll
      for (int h = 0; h < 4; ++h) { m[h] = 0.f; l[h] = 0.f; o[h] = (f32x4){0.f, 0.f, 0.f, 0.f}; }
      const f32x4 cbv = *(const f32x4*)(a.CB + 64 + 4 * d4);
#pragma unroll
      for (int it = 0; it < 4; ++it) { const int c = 16 * w + 4 * it + kq; const int cc = c < 127 ? c : 126;
          const f32x4 vx = *(const f32x4*)(pqv + (size_t)cc * 256 + 128) + *(const f32x4*)(pqv + (size_t)(cc + 1) * 256 + 192) + cbv;
#pragma unroll
          for (int h = 0; h < 4; ++h) { const float p = c < 127 ? sc[h * 128 + cc] : 0.f; o[h] = o[h] + vx * p; l[h] += p; } }
      ocmp = smp_merge(m, l, o, lds, tid);
    }
    const unsigned long long mask = *maskp;
#pragma unroll
    for (int h = 0; h < 4; ++h) qv[h] = *(const LAS f32x4*)(qr + h * 64 + 4 * d4);
    float oslc;
    { float m[4], l[4]; f32x4 o[4];
#pragma unroll
      for (int h = 0; h < 4; ++h) { m[h] = -1e30f; l[h] = 0.f; o[h] = (f32x4){0.f, 0.f, 0.f, 0.f}; }
#pragma unroll 1
      for (int bi = 0; bi < 2; ++bi) { const int j = nth_bit(mask, 2 * w + bi);
          if (j < 32) { const int phys = a.page_table[b * 16 + (j >> 1)];
              const float* base = a.cache_kv + ((size_t)phys * 128 + (j & 1) * 64 + kq) * 1024 + 512 + g * 64 + 4 * d4;
#pragma unroll 1
              for (int it8 = 0; it8 < 2; ++it8) { const float* p0 = base + (size_t)it8 * 32 * 1024; f32x4 kx[8], vx[8];
#pragma unroll
                  for (int u = 0; u < 8; ++u) { kx[u] = *(const f32x4*)(p0 + u * 4096); vx[u] = *(const f32x4*)(p0 + u * 4096 + 256); }
                  smp_batch(kx, vx, qv, m, l, o); } }
          else { const float* p0 = a.out + OFF_KVS + (size_t)b * 1024 + 512 + g * 64 + 4 * d4;
              const f32x4 kx = *(const f32x4*)p0, vx = *(const f32x4*)(p0 + 256); smp_update(kx, vx, kq == 0, qv, m, l, o); } }
      oslc = smp_merge(m, l, o, lds, tid);
    }
    float owin;
    { float m[4], l[4]; f32x4 o[4];
#pragma unroll
      for (int h = 0; h < 4; ++h) { m[h] = -1e30f; l[h] = 0.f; o[h] = (f32x4){0.f, 0.f, 0.f, 0.f}; }
#pragma unroll 1
      for (int it8 = 0; it8 < 2; ++it8) { f32x4 kx[8], vx[8];
#pragma unroll
          for (int u = 0; u < 8; ++u) { const int kk = 64 * w + 32 * it8 + 4 * u + kq;
              const float* p0 = kk < 511 ? a.cache_win + (((size_t)b * 512 + kk + 1) * 2) * 256 + g * 64 + 4 * d4 : a.out + OFF_WINS + (size_t)b * 512 + g * 64 + 4 * d4;
              kx[u] = *(const f32x4*)p0; vx[u] = *(const f32x4*)(p0 + 256); }
          smp_batch(kx, vx, qv, m, l, o); }
      owin = smp_merge(m, l, o, lds, tid);
    }
    if (tid < 256) { const int oh = tid >> 6, oe = tid & 63; const float* gp = a.G + row * 48 + g * 12 + oh * 3;
        const float ov = gp[0] * ocmp + gp[1] * oslc + gp[2] * owin;
        a.O[row * D + (4 * g + oh) * 64 + oe] = (bf16)(pk2(ov, 0.f) & 0xffffu); }
    __syncthreads();
}

constexpr int SK_RED = 0;
template <bool FIRST> __device__ __forceinline__ void skinny_resid(const bf16* __restrict__ A, const bf16* __restrict__ Bt, int K, const float* xs, bf16* XB, float* SS, int u, LAS unsigned char* lds, int tid) {
    typedef float f32x4v __attribute__((ext_vector_type(4)));
    asm volatile("" : "+v"(tid));
    const int lane = tid & 63, w = __builtin_amdgcn_readfirstlane(tid >> 6), r16 = lane & 15, kq = lane >> 4, rt = u & 7, cu = u >> 3;
    const bf16* ap = A + (size_t)(NP + 16 * rt + r16) * K + 8 * kq + 32 * w;
    const bf16* bp = Bt + (size_t)(64 * cu + r16) * K + 8 * kq + 32 * w;
    f32x4v acc[4];
#pragma unroll
    for (int ct = 0; ct < 4; ++ct) acc[ct] = (f32x4v){0.f, 0.f, 0.f, 0.f};
    const int nj = K / 256;
#pragma unroll 1
    for (int j0 = 0; j0 < nj; j0 += 4) { bf16x8 af[4], bf[4][4];
#pragma unroll
        for (int s = 0; s < 4; ++s) { const int j = (j0 + s < nj) ? j0 + s : nj - 1;
            af[s] = *(const bf16x8*)(ap + 256 * j);
#pragma unroll
            for (int ct = 0; ct < 4; ++ct) bf[s][ct] = *(const bf16x8*)(bp + (size_t)16 * ct * K + 256 * j); }
        __builtin_amdgcn_sched_barrier(0);
#pragma unroll
        for (int s = 0; s < 4; ++s) if (j0 + s < nj) {
#pragma unroll
            for (int ct = 0; ct < 4; ++ct) acc[ct] = __builtin_amdgcn_mfma_f32_16x16x32_bf16(af[s], bf[s][ct], acc[ct], 0, 0, 0); }
        __builtin_amdgcn_sched_barrier(0); }
    LAS float* red = (LAS float*)(lds + SK_RED);
#pragma unroll
    for (int ct = 0; ct < 4; ++ct) *(LAS f32x4v*)(red + ((w * 4 + ct) * 64 + lane) * 4) = acc[ct];
    __syncthreads();
#pragma unroll
    for (int rr = 0; rr < 2; ++rr) { const int lr = 2 * w + rr;
        const int ct = lane >> 4, src_lane = (lr >> 2) * 16 + (lane & 15), reg = lr & 3;
        float s = 0.f;
#pragma unroll
        for (int ww = 0; ww < 8; ++ww) s += red[((ww * 4 + ct) * 64 + src_lane) * 4 + reg];
        const int srow = 16 * rt + lr; const size_t row = (size_t)NP + srow; const int col = 64 * cu + lane;
        const float x = (FIRST ? xs[(size_t)srow * D + col] : bf1(XB[row * D + col])) + s;
        XB[row * D + col] = (bf16)(pk2(x, 0.f) & 0xffffu);
        const float sq = wave_sum(x * x);
        if (lane == 0) SS[row * 16 + cu] = sq; }
    __syncthreads();
}


struct Args { const float* in[21]; float* out; unsigned char* ws; };
__global__ void __launch_bounds__(NWAVES * 64, 2) nsa_fwd(Args args) {
    extern __shared__ __attribute__((aligned(16))) unsigned char lds_raw[];
    LAS unsigned char* lds = (LAS unsigned char*)lds_raw;
    volatile LAS unsigned* MISC = (volatile LAS unsigned*)(lds + MISC_OFF);
    const int tid = threadIdx.x;
    const int wave_s = __builtin_amdgcn_readfirstlane(tid >> 6);
    const int G = gridDim.x; const int bx = blockIdx.x; const int vcu = (G % 8 == 0) ? (bx % 8) * (G / 8) + bx / 8 : bx;
    const int NGW = G * NWAVES;
    unsigned char* ws = args.ws; float* out = args.out;
    gu32* ctl = (gu32*)(ws + WS_CTL);
    const float* x_prompt = args.in[0]; const float* x_sample = args.in[1]; const float* state_conv = args.in[2]; const float* cache_kv = args.in[3]; const float* cache_win = args.in[4];
    const int* page_table = (const int*)args.in[5];
    const float* norm_mix = args.in[6]; const float* norm_ffn = args.in[7]; const float* norm_final = args.in[8]; const float* w_in0 = args.in[9]; const float* conv_w = args.in[10];
    const float* norm_v = args.in[11]; const float* w_spatial = args.in[12]; const float* b_spatial = args.in[13]; const float* w_out0 = args.in[14]; const float* w_in1 = args.in[15];
    const float* pe_cmp = args.in[16]; const float* w_cmp = args.in[17]; const float* w_out1 = args.in[18]; const float* w_ffn_in = args.in[19]; const float* w_ffn_out = args.in[20];
    for (int u = tid; u < (LDS_BYTES - LDSCTL_OFF) / 4; u += NWAVES * 64) ((LAS unsigned*)(lds + LDSCTL_OFF))[u] = 0u;
    __syncthreads();
    XcdBarrier bar = xcd_barrier_post((unsigned*)(ctl + CW_BAR), MISC + 8);
#define GRID_BAR() xcd_barrier(bar)
#define WS_PTRS() GAS unsigned char* ws_g = (GAS unsigned char*)ws; asm volatile("" : "+s"(ws_g)); unsigned char* ws_p = (unsigned char*)ws_g;     \
    bf16* W0IN = (bf16*)(ws_p + WS_W0IN); bf16* W0OUT = (bf16*)(ws_p + WS_W0OUT); bf16* WFI0 = (bf16*)(ws_p + WS_WFI0); bf16* WFI1 = (bf16*)(ws_p + WS_WFI1); bf16* WFO0 = (bf16*)(ws_p + WS_WFO0); bf16* WFO1 = (bf16*)(ws_p + WS_WFO1); \
    bf16* W1IN = (bf16*)(ws_p + WS_W1IN); bf16* W1OUT = (bf16*)(ws_p + WS_W1OUT); bf16* WCMP = (bf16*)(ws_p + WS_WCMP); \
    float* SS = (float*)(ws_p + WS_SS); float* CB = (float*)(ws_p + WS_CBIAS); float* GT = (float*)(ws_p + WS_G); float* X = (float*)(ws_p + WS_X); bf16* XB = (bf16*)(ws_p + WS_XB); \
    bf16* H0 = (bf16*)(ws_p + WS_H0); bf16* YC = (bf16*)(ws_p + WS_YC); bf16* ACT = (bf16*)(ws_p + WS_ACT); float* H1 = (float*)(ws_p + WS_H1); bf16* Qb = (bf16*)(ws_p + WS_Q); bf16* QRb = (bf16*)(ws_p + WS_QR); \
    bf16* Ob = (bf16*)(ws_p + WS_O); bf16* CMPA = (bf16*)(ws_p + WS_CMPA); bf16* KVB = (bf16*)(ws_p + WS_KVB); float* PQ = (float*)(ws_p + WS_PQ); \
    (void)W0IN; (void)W0OUT; (void)WFI0; (void)WFI1; (void)WFO0; (void)WFO1; (void)W1IN; (void)W1OUT; (void)WCMP; (void)SS; (void)CB; (void)GT; (void)X; (void)XB; (void)H0; (void)YC; (void)ACT; (void)H1; (void)Qb; (void)QRb; (void)Ob; (void)CMPA; (void)KVB; (void)PQ
#define PHASE_IDS() const int tid_p = fresh_tid(wave_s); const int lane_p = tid_p & 63, wave_p = __builtin_amdgcn_readfirstlane(tid_p >> 6), gw_p = vcu * NWAVES + wave_p; (void)lane_p; (void)gw_p

    { WS_PTRS(); const P0Args pa{x_prompt, x_sample, norm_mix, norm_ffn, w_in0, w_out0, w_in1, pe_cmp, w_cmp, w_out1, w_ffn_in, w_ffn_out, ws};
      PHASE_IDS(); p0_prologue(pa, lds, gw_p, NGW, wave_p, lane_p); }
    GRID_BAR();
    { WS_PTRS();
      { const int nwg = (MP / 256) * (N_IN0 / 256), fi_ = nwg - ((nwg - 1) / G) * G, first_idle = fi_ < G ? fi_ : 0;
        if (bx >= first_idle) { PHASE_IDS(); const P0Args pa{x_prompt, x_sample, norm_mix, norm_ffn, w_in0, w_out0, w_in1, pe_cmp, w_cmp, w_out1, w_ffn_in, w_ffn_out, ws};
            tr_run(pa, 1, TRG_N1, (bx - first_idle) * NWAVES + wave_p, (G - first_idle) * NWAVES, (LAS float*)(lds + RING_OFF + wave_p * 16384), lane_p); __syncthreads(); } }
      pg8::Gemm g{XB, W0IN, MP, N_IN0, D}; pg8::StaticOrder S; S.init(MP, N_IN0, G, bx);
      pg8::EpiScaleBf16 E{H0, N_IN0, SS, (float*)(ws_p + WS_VSS)};
      pg8::gemm_phase<pg8::EpiScaleBf16, pg8::StaticOrder, true, true>(lds + RING_OFF, g, S, E, fresh_tid(wave_s)); }
    GRID_BAR();
    { WS_PTRS(); const P2Args pa{H0, YC, conv_w, norm_v, w_spatial, b_spatial, state_conv, (const float*)(ws_p + WS_VSS), out};
      PHASE_IDS();
      for (int u = vcu; u < 512; u += G) p2_unit(pa, u, lds, tid_p);
      for (int b = gw_p; b < NSMP; b += NGW) p2_sample_row(pa, b, lane_p);
      if (gw_p >= NGW - 2) { const int type = gw_p - (NGW - 2); const float* cp = (const float*)(ws_p + WS_CBIAS + 4096) + (size_t)type * 32 * 64 + lane_p; float s = 0.f;
#pragma unroll
          for (int c = 0; c < 32; ++c) s += cp[c * 64];
          CB[type * 64 + lane_p] = s; } }
    GRID_BAR();
    { WS_PTRS(); pg8::Gemm g{YC, W0OUT, NP, D, D}; pg8::StaticOrder S; S.init(NP, D, G, bx);
      pg8::EpiResid<false> E{nullptr, nullptr, XB, SS};
      pg8::gemm_phase<pg8::EpiResid<false>, pg8::StaticOrder, true, true>(lds + RING_OFF, g, S, E, fresh_tid(wave_s));
      PHASE_IDS(); __syncthreads();
#pragma unroll 1
      for (int u2 = vcu; u2 < 128; u2 += G) skinny_resid<false>(YC, W0OUT, D, nullptr, XB, SS, u2, lds, tid_p);
      { const int first = G > 128 ? 128 : 0;
        if (vcu >= first) { const P0Args pa{x_prompt, x_sample, norm_mix, norm_ffn, w_in0, w_out0, w_in1, pe_cmp, w_cmp, w_out1, w_ffn_in, w_ffn_out, ws};
            tr_run(pa, 4, TRG_N4, (vcu - first) * NWAVES + wave_p, (G - first) * NWAVES, (LAS float*)(lds + RING_OFF + wave_p * 16384), lane_p); } } }
    GRID_BAR();
    { WS_PTRS();
      { const int nwg = (MP / 256) * (N_FF2 / 256), fi_ = nwg - ((nwg - 1) / G) * G, first_idle = fi_ < G ? fi_ : 0;
        if (bx >= first_idle) { PHASE_IDS(); const P0Args pa{x_prompt, x_sample, norm_mix, norm_ffn, w_in0, w_out0, w_in1, pe_cmp, w_cmp, w_out1, w_ffn_in, w_ffn_out, ws};
            tr_run(pa, 2, TRG_N2, (bx - first_idle) * NWAVES + wave_p, (G - first_idle) * NWAVES, (LAS float*)(lds + RING_OFF + wave_p * 16384), lane_p); __syncthreads(); } }
      pg8::Gemm g{XB, WFI0, MP, N_FF2, D}; pg8::StaticOrder S; S.init(MP, N_FF2, G, bx);
      pg8::EpiSwiGLU E{ACT, DFF, SS};
      pg8::gemm_phase<pg8::EpiSwiGLU, pg8::StaticOrder, true, true>(lds + RING_OFF, g, S, E, fresh_tid(wave_s)); }
    GRID_BAR();
    { WS_PTRS(); pg8::Gemm g{ACT, WFO0, NP, D, DFF}; pg8::StaticOrder S; S.init(NP, D, G, bx);
      pg8::EpiResid<false> E{nullptr, nullptr, XB, SS};
      pg8::gemm_phase<pg8::EpiResid<false>, pg8::StaticOrder, true, true>(lds + RING_OFF, g, S, E, fresh_tid(wave_s));
      PHASE_IDS(); __syncthreads();
#pragma unroll 1
      for (int u2 = vcu; u2 < 128; u2 += G) skinny_resid<false>(ACT, WFO0, DFF, nullptr, XB, SS, u2, lds, tid_p);
      { const int first = G > 128 ? 128 : 0;
        if (vcu >= first) { const P0Args pa{x_prompt, x_sample, norm_mix, norm_ffn, w_in0, w_out0, w_in1, pe_cmp, w_cmp, w_out1, w_ffn_in, w_ffn_out, ws};
            tr_run(pa, 5, TRG_N5, (vcu - first) * NWAVES + wave_p, (G - first) * NWAVES, (LAS float*)(lds + RING_OFF + wave_p * 16384), lane_p); } } }
    GRID_BAR();
    { WS_PTRS();
      { const int nwg = (MP / 256) * (N_IN1P / 256), fi_ = nwg - ((nwg - 1) / G) * G, first_idle = fi_ < G ? fi_ : 0;
        if (bx >= first_idle) { PHASE_IDS(); const P0Args pa{x_prompt, x_sample, norm_mix, norm_ffn, w_in0, w_out0, w_in1, pe_cmp, w_cmp, w_out1, w_ffn_in, w_ffn_out, ws};
            tr_run(pa, 3, TRG_N3, (bx - first_idle) * NWAVES + wave_p, (G - first_idle) * NWAVES, (LAS float*)(lds + RING_OFF + wave_p * 16384), lane_p); __syncthreads(); } }
      pg8::Gemm g{XB, W1IN, MP, N_IN1P, D}; pg8::StaticOrder S; S.init(MP, N_IN1P, G, bx);
      pg8::EpiNsa E{SS, Qb, QRb, KVB, GT, out, OFF_KVP, OFF_KVS, OFF_WINP, OFF_WINS, KVB_TY, C2};
      pg8::gemm_phase<pg8::EpiNsa, pg8::StaticOrder, true, true>(lds + RING_OFF, g, S, E, fresh_tid(wave_s)); }
    GRID_BAR();
    { WS_PTRS(); PHASE_IDS();
#pragma unroll 1
      for (int u = vcu; u < 256; u += G) cmp_prompt_unit(KVB, WCMP, PQ, u, lds, tid_p); }
    GRID_BAR();
    { WS_PTRS(); const AttnArgs pa{Qb, QRb, KVB, PQ, CB, GT, Ob}; PHASE_IDS();
      unsigned* flags = (unsigned*)(ws_p + WS_CTL) + CW_FLAG;
      const SmpArgs sa{Qb, QRb, PQ, CB, GT, cache_kv, cache_win, page_table, out, Ob, flags};
      const CmpArgs ca{cache_kv, page_table, WCMP, PQ, flags};
      { int last_ng = -1; const int ccls = vcu % 4, bq = (vcu >> 2) & 3, scls = (bq & 1) ? 4 : (bq == 0 && ccls <= 2) ? 2 : 3;
#pragma unroll 1
      for (int step = 0; step < 5; ++step) {
          if (step == ccls) {
#pragma unroll 1
              for (int u = vcu; u < 2 * NSMP; u += G) cmp_sample_unit(ca, u >> 1, u & 1, lds + A_RING, fresh_tid(wave_s)); }
          if (step == scls) {
#pragma unroll 1
              for (int it = vcu; it < NSMP * 4; it += G) attn_sample_item(sa, it >> 2, it & 3, lds, fresh_tid(wave_s)); }
          if (step < 4) {
#pragma unroll 1
              for (int idx = vcu + step * G; idx < 1024; idx += 4 * G) { int ng, qt;
                  if (G == 256) { const int k = idx >> 8, v = idx & 255, s = v & 15; ng = v >> 4; qt = k == 0 ? s : k == 1 ? 31 - s : k == 2 ? 32 + s : 63 - s; }
                  else { ng = idx >> 6; qt = idx & 63; }
                  if (ng != last_ng) { attn_build_ckcv(pa, ng, lds, fresh_tid(wave_s)); last_ng = ng; }
                  attn_prompt_unit(pa, ng >> 2, ng & 3, qt, lds, fresh_tid(wave_s)); } } } } }
    GRID_BAR();
    { WS_PTRS(); pg8::Gemm g{Ob, W1OUT, NP, D, D}; pg8::StaticOrder S; S.init(NP, D, G, bx);
      pg8::EpiResid<false> E{nullptr, nullptr, XB, SS};
      pg8::gemm_phase<pg8::EpiResid<false>, pg8::StaticOrder, true, true>(lds + RING_OFF, g, S, E, fresh_tid(wave_s));
      PHASE_IDS(); __syncthreads();
#pragma unroll 1
      for (int u2 = vcu; u2 < 128; u2 += G) skinny_resid<false>(Ob, W1OUT, D, nullptr, XB, SS, u2, lds, tid_p); }
    GRID_BAR();
    { WS_PTRS(); pg8::Gemm g{XB, WFI1, MP, N_FF2, D}; pg8::StaticOrder S; S.init(MP, N_FF2, G, bx);
      pg8::EpiSwiGLU E{ACT, DFF, SS};
      pg8::gemm_phase<pg8::EpiSwiGLU, pg8::StaticOrder, true, true>(lds + RING_OFF, g, S, E, fresh_tid(wave_s)); }
    GRID_BAR();
    { WS_PTRS(); pg8::Gemm g{ACT, WFO1, NP, D, DFF}; pg8::StaticOrder S; S.init(NP, D, G, bx);
      pg8::EpiResid<false> E{nullptr, nullptr, XB, SS};
      pg8::gemm_phase<pg8::EpiResid<false>, pg8::StaticOrder, true, true>(lds + RING_OFF, g, S, E, fresh_tid(wave_s));
      PHASE_IDS(); __syncthreads();
#pragma unroll 1
      for (int u2 = vcu; u2 < 128; u2 += G) skinny_resid<false>(ACT, WFO1, DFF, nullptr, XB, SS, u2, lds, tid_p); }
    GRID_BAR();
    { WS_PTRS(); PHASE_IDS();
    for (int row = gw_p; row < MR; row += NGW) {
        const float rs = pg8::row_rs(SS, row); const u32x2* xr = (const u32x2*)(XB + (size_t)row * D) + lane_p; const f32x4* gr = (const f32x4*)norm_final + lane_p;
        f32x4* o = (f32x4*)(row < NP ? out + OFF_Y + (size_t)row * D : out + OFF_YS + (size_t)(row - NP) * D) + lane_p;
#pragma unroll
        for (int j = 0; j < 4; ++j) { const u32x2 xb = xr[64 * j]; const f32x4 xv = (f32x4){bflo(xb.x), bfhi(xb.x), bflo(xb.y), bfhi(xb.y)}; o[64 * j] = xv * rs * gr[64 * j]; }
    } }

#undef GRID_BAR
}

extern "C" void kernel_launch(void* const* d_in, const int* in_sizes, int n_in, void* d_out, int out_size, void* d_ws, size_t ws_size, hipStream_t stream) {
    static int grid = 0;
    if (grid == 0) {
        if (n_in != 21 || (size_t)out_size != OUT_TOTAL || ws_size < WS_END) { fprintf(stderr, "kernel_launch: unexpected sizes (n_in %d, out %d, ws %zu); nothing launched\n", n_in, out_size, ws_size); grid = -1; return; }
        int dev = 0, cus = 0, per_cu = 0;
        if (hipGetDevice(&dev) != hipSuccess || hipDeviceGetAttribute(&cus, hipDeviceAttributeMultiprocessorCount, dev) != hipSuccess) { fprintf(stderr, "kernel_launch: device query failed\n"); grid = -1; return; }
        if (hipFuncSetAttribute((const void*)nsa_fwd, hipFuncAttributeMaxDynamicSharedMemorySize, LDS_BYTES) != hipSuccess) { fprintf(stderr, "kernel_launch: hipFuncSetAttribute failed\n"); grid = -1; return; }
        if (hipOccupancyMaxActiveBlocksPerMultiprocessor(&per_cu, (const void*)nsa_fwd, NWAVES * 64, LDS_BYTES) != hipSuccess || per_cu < 1)
            fprintf(stderr, "kernel_launch: note: occupancy query reports %d workgroups per CU\n", per_cu);
        (void)hipGetLastError();
        grid = cus;
    }
    if (grid < 0) return;
    if (hipMemsetAsync((char*)d_ws + WS_CTL, 0, CTL_ZERO_BYTES, stream) != hipSuccess) { fprintf(stderr, "kernel_launch: memset failed\n"); return; }
    Args a{};
    for (int i = 0; i < 21; ++i) a.in[i] = (const float*)d_in[i];
    a.out = (float*)d_out; a.ws = (unsigned char*)d_ws;
    hipLaunchKernelGGL(nsa_fwd, dim3(grid), dim3(NWAVES * 64), LDS_BYTES, stream, a);
    const hipError_t le = hipPeekAtLastError();
    if (le != hipSuccess) fprintf(stderr, "kernel_launch: launch failed: %s\n", hipGetErrorName(le));
}
```
